# Optimizing an MI355X kernel written in HIP

```python
import jax, jax.numpy as jnp
from jax import lax
import numpy as np

D_MODEL = 2048
BATCH = 4
SEQ = 2048
DEPTH = 1

RWKV_HEADS = 16
RWKV_HEAD_DIM = 64
RWKV_WIDTH = RWKV_HEADS * RWKV_HEAD_DIM
LORA_DECAY = 96
LORA_ICLR = 96
LORA_GATE = 256
GN_EPS = 64e-5
RWKV_COLS = 3 * RWKV_WIDTH + LORA_DECAY + LORA_ICLR + LORA_GATE
NSA_HEADS = 16
NSA_KV_HEADS = 4
NSA_GROUP = NSA_HEADS // NSA_KV_HEADS
NSA_HEAD_DIM = 64
NSA_Q_WIDTH = NSA_HEADS * NSA_HEAD_DIM
NSA_KV_WIDTH = NSA_KV_HEADS * NSA_HEAD_DIM
CMP_BLOCK = 32
CMP_STRIDE = 16
CMP_HIDDEN = 256
SEL_BLOCK = 64
SEL_TOPN = 16
WINDOW = 512
SEL_QBLK = 64
WIN_QBLK = 128
NSA_COLS = NSA_Q_WIDTH + 6 * NSA_KV_WIDTH + 3 * NSA_HEADS
GATE_COLS = 2 * D_MODEL
IN_COLS = RWKV_COLS + NSA_COLS + GATE_COLS
D_FF = 4 * D_MODEL
NORM_EPS = 1e-5
NEG_INF = -1e30
TINY = 1e-30

kernel_name = "rwkv7_nsa_gated_hybrid_block"


def rmsnorm(x, g):
    x32 = x.astype(jnp.float32)
    y = x32 * lax.rsqrt(jnp.mean(x32 * x32, axis=-1, keepdims=True) + NORM_EPS)
    return (y * g.astype(jnp.float32)).astype(x.dtype)


def masked_softmax(s, mask):
    s = jnp.where(mask, s, NEG_INF)
    s = s - jnp.max(s, axis=-1, keepdims=True)
    p = jnp.exp(s) * mask.astype(jnp.float32)
    return p / jnp.maximum(jnp.sum(p, axis=-1, keepdims=True), TINY)


def alibi_slopes(n):
    return 2.0 ** (-8.0 * jnp.arange(1, n + 1, dtype=jnp.float32) / n)


def to_chunks(t, axis, size):
    shp = t.shape
    t = t.reshape(shp[:axis] + (shp[axis] // size, size) + shp[axis + 1:])
    return jnp.moveaxis(t, axis, 0)


def from_chunks(o):
    o = jnp.moveaxis(o, 0, 3)
    b, g, hg, nc, qb, d = o.shape
    return o.reshape(b, g, hg, nc * qb, d).transpose(0, 3, 1, 2, 4)


def rwkv7_time_mix(z, mu, w0, w_up, a0, a_up, g_up, k_k, k_a, r_k, lnx_w, lnx_b):
    B, T, _ = z.shape
    H, N = RWKV_HEADS, RWKV_HEAD_DIM
    z_prev = jnp.pad(z, ((0, 0), (1, 0), (0, 0)))[:, :-1]
    z = z + (z_prev - z) * mu
    offs = [int(o) for o in np.cumsum([RWKV_WIDTH, RWKV_WIDTH, RWKV_WIDTH, LORA_DECAY, LORA_ICLR])]
    r, k, v, w_lo, a_lo, g_lo = jnp.split(z, offs, axis=-1)
    w_log = -jax.nn.softplus(-(w0 + jnp.tanh(w_lo) @ w_up)) - 0.5
    a = jax.nn.sigmoid(a0 + a_lo @ a_up)
    g = jax.nn.sigmoid(g_lo) @ g_up
    heads = lambda t: t.astype(jnp.float32).reshape(B, T, H, N)
    r, k, v, a = heads(r), heads(k), heads(v), heads(a)
    decay = jnp.exp(-jnp.exp(heads(w_log)))
    kk = k * k_k
    kk = kk * lax.rsqrt(jnp.maximum(jnp.sum(kk * kk, axis=-1, keepdims=True), 1e-24))
    k = k * (1.0 + (a - 1.0) * k_a)

    def step(S, inp):
        r_t, w_t, k_t, v_t, kk_t, a_t = inp
        sa = jnp.einsum('bhij,bhj->bhi', S, -kk_t)
        S = S * w_t[:, :, None, :] + sa[..., None] * (kk_t * a_t)[:, :, None, :] + v_t[..., None] * k_t[:, :, None, :]
        return S, jnp.einsum('bhij,bhj->bhi', S, r_t)

    xs = tuple(jnp.moveaxis(t, 1, 0) for t in (r, decay, k, v, kk, a))
    _, y = lax.scan(step, jnp.zeros((B, H, N, N), jnp.float32), xs)
    y = jnp.moveaxis(y, 0, 1)
    mean = jnp.mean(y, axis=-1, keepdims=True)
    var = jnp.mean(jnp.square(y - mean), axis=-1, keepdims=True)
    y = ((y - mean) * lax.rsqrt(var + GN_EPS)).reshape(B, T, RWKV_WIDTH) * lnx_w + lnx_b
    bonus = (jnp.sum(r * k * r_k, axis=-1, keepdims=True) * v).reshape(B, T, RWKV_WIDTH)
    return ((y + bonus) * g).astype(z.dtype)


def compress(kv, pe, w1, w2):
    B, T, G, d = kv.shape
    n_cmp = (T - CMP_BLOCK) // CMP_STRIDE + 1
    idx = np.arange(n_cmp)[:, None] * CMP_STRIDE + np.arange(CMP_BLOCK)[None, :]
    blk = kv[:, idx] + pe[:, None, :]
    blk = blk.transpose(0, 1, 3, 2, 4).reshape(B, n_cmp, G, CMP_BLOCK * d)
    return jax.nn.gelu(blk @ w1) @ w2


def nsa_attention(q, kc_raw, vc_raw, ks, vs, kw, vw, gate_logits,
                  cmp_pe_k, cmp_w1_k, cmp_w2_k, cmp_pe_v, cmp_w1_v, cmp_w2_v):
    B, T, _ = q.shape
    G, Hg, d = NSA_KV_HEADS, NSA_GROUP, NSA_HEAD_DIM
    scale = d ** -0.5
    kvh = lambda t: t.reshape(B, T, G, d)
    qg = q.reshape(B, T, G, Hg, d)
    slopes = alibi_slopes(NSA_HEADS).reshape(G, Hg)[None, :, :, None, None]
    tpos = jnp.arange(T)

    kc = compress(kvh(kc_raw), cmp_pe_k, cmp_w1_k, cmp_w2_k)
    vc = compress(kvh(vc_raw), cmp_pe_v, cmp_w1_v, cmp_w2_v)
    n_cmp = kc.shape[1]
    ends = jnp.arange(n_cmp) * CMP_STRIDE + (CMP_BLOCK - 1)
    dist_c = (tpos[:, None] - ends[None, :]).astype(jnp.float32)
    s_c = jnp.einsum('btghd,bngd->bghtn', qg, kc).astype(jnp.float32) * scale - slopes * dist_c
    p_cmp = masked_softmax(s_c, dist_c >= 0)
    o_cmp = jnp.einsum('bghtn,bngd->btghd', p_cmp.astype(vc.dtype), vc)

    n_sel = T // SEL_BLOCK
    n_top = min(SEL_TOPN, n_sel)
    cs = np.arange(n_cmp)[:, None] * CMP_STRIDE
    ss = np.arange(n_sel)[None, :] * SEL_BLOCK
    overlap = np.clip(np.minimum(cs + CMP_BLOCK, ss + SEL_BLOCK) - np.maximum(cs, ss), 0, None) / CMP_BLOCK
    imp = jnp.einsum('bghtn,nj->bgtj', p_cmp, jnp.asarray(overlap, jnp.float32))
    blk = jnp.arange(n_sel)[None, :]
    cur = (tpos // SEL_BLOCK)[:, None]
    forced = (blk == 0) | (blk == cur) | (blk == cur - 1)
    score = jnp.where(blk > cur, NEG_INF, jnp.where(forced, -NEG_INF, imp))
    top_val, top_idx = lax.top_k(score, n_top)
    top_ok = top_val > 0.5 * NEG_INF

    qh = qg.transpose(0, 2, 3, 1, 4)

    k_blk = kvh(ks).transpose(0, 2, 1, 3).reshape(B, G, n_sel, SEL_BLOCK, d)
    v_blk = kvh(vs).transpose(0, 2, 1, 3).reshape(B, G, n_sel, SEL_BLOCK, d)
    bi = jnp.arange(B)[:, None, None, None]
    gi = jnp.arange(G)[None, :, None, None]

    def sel_block(args):
        q_c, idx_c, ok_c, t0 = args
        kg = k_blk[bi, gi, idx_c].reshape(B, G, SEL_QBLK, n_top * SEL_BLOCK, d)
        vg = v_blk[bi, gi, idx_c].reshape(B, G, SEL_QBLK, n_top * SEL_BLOCK, d)
        pos = (idx_c[..., None] * SEL_BLOCK + jnp.arange(SEL_BLOCK)).reshape(B, G, SEL_QBLK, n_top * SEL_BLOCK)
        tq = t0 + jnp.arange(SEL_QBLK)
        dist = (tq[:, None] - pos).astype(jnp.float32)
        mask = jnp.repeat(ok_c, SEL_BLOCK, axis=-1) & (dist >= 0)
        s = jnp.einsum('bghqd,bgqkd->bghqk', q_c, kg).astype(jnp.float32) * scale - slopes * dist[:, :, None]
        p = masked_softmax(s, mask[:, :, None])
        return jnp.einsum('bghqk,bgqkd->bghqd', p.astype(vg.dtype), vg)

    o_slc = from_chunks(lax.map(sel_block, (to_chunks(qh, 3, SEL_QBLK), to_chunks(top_idx, 2, SEL_QBLK),
                                            to_chunks(top_ok, 2, SEL_QBLK), jnp.arange(T // SEL_QBLK) * SEL_QBLK)))

    pad = ((0, 0), (0, 0), (WINDOW, 0), (0, 0))
    kwp = jnp.pad(kvh(kw).transpose(0, 2, 1, 3), pad)
    vwp = jnp.pad(kvh(vw).transpose(0, 2, 1, 3), pad)
    span = WINDOW + WIN_QBLK

    def win_block(args):
        q_c, t0 = args
        kb = lax.dynamic_slice_in_dim(kwp, t0, span, axis=2)
        vb = lax.dynamic_slice_in_dim(vwp, t0, span, axis=2)
        tq = t0 + jnp.arange(WIN_QBLK)
        pos = t0 - WINDOW + jnp.arange(span)
        dist = (tq[:, None] - pos[None, :]).astype(jnp.float32)
        mask = (pos[None, :] >= 0) & (dist >= 0) & (dist < WINDOW)
        s = jnp.einsum('bghqd,bgkd->bghqk', q_c, kb).astype(jnp.float32) * scale - slopes * dist
        p = masked_softmax(s, mask)
        return jnp.einsum('bghqk,bgkd->bghqd', p.astype(vb.dtype), vb)

    o_win = from_chunks(lax.map(win_block, (to_chunks(qh, 3, WIN_QBLK), jnp.arange(T // WIN_QBLK) * WIN_QBLK)))

    gates = jax.nn.sigmoid(gate_logits.astype(jnp.float32)).reshape(B, T, 3, G, Hg, 1)
    o = gates[:, :, 0] * o_cmp + gates[:, :, 1] * o_slc + gates[:, :, 2] * o_win
    return o.reshape(B, T, NSA_Q_WIDTH).astype(q.dtype)


def setup_inputs(seed: int = 0) -> dict:
    key = jax.random.key(seed)
    ks = jax.random.split(key, 32)
    nrm = lambda k, shape, sc: sc * jax.random.normal(k, shape, jnp.float32)
    L, H, N, d = DEPTH, RWKV_HEADS, RWKV_HEAD_DIM, NSA_HEAD_DIM
    return {
        "x": nrm(ks[0], (BATCH, SEQ, D_MODEL), 1.0),
        "norm_mix": 1.0 + nrm(ks[1], (L, D_MODEL), 0.02),
        "w_in": nrm(ks[2], (L, D_MODEL, IN_COLS), D_MODEL ** -0.5),
        "rwkv_mu": jax.random.uniform(ks[3], (L, RWKV_COLS), jnp.float32),
        "rwkv_w0": jnp.linspace(-6.0, -0.5, RWKV_WIDTH)[None, :] + nrm(ks[4], (L, RWKV_WIDTH), 0.1),
        "rwkv_w_up": nrm(ks[5], (L, LORA_DECAY, RWKV_WIDTH), 0.1 * LORA_DECAY ** -0.5),
        "rwkv_a0": nrm(ks[6], (L, RWKV_WIDTH), 0.1),
        "rwkv_a_up": nrm(ks[7], (L, LORA_ICLR, RWKV_WIDTH), LORA_ICLR ** -0.5),
        "rwkv_g_up": nrm(ks[8], (L, LORA_GATE, RWKV_WIDTH), LORA_GATE ** -0.5),
        "rwkv_k_k": 0.85 + nrm(ks[9], (L, H, N), 0.02),
        "rwkv_k_a": 1.0 + nrm(ks[10], (L, H, N), 0.02),
        "rwkv_r_k": nrm(ks[11], (L, H, N), 0.1),
        "rwkv_lnx_w": 1.0 + nrm(ks[12], (L, RWKV_WIDTH), 0.02),
        "rwkv_lnx_b": nrm(ks[13], (L, RWKV_WIDTH), 0.02),
        "cmp_pe_k": nrm(ks[14], (L, CMP_BLOCK, d), 0.02),
        "cmp_w1_k": nrm(ks[15], (L, CMP_BLOCK * d, CMP_HIDDEN), (CMP_BLOCK * d) ** -0.5),
        "cmp_w2_k": nrm(ks[16], (L, CMP_HIDDEN, d), CMP_HIDDEN ** -0.5),
        "cmp_pe_v": nrm(ks[17], (L, CMP_BLOCK, d), 0.02),
        "cmp_w1_v": nrm(ks[18], (L, CMP_BLOCK * d, CMP_HIDDEN), (CMP_BLOCK * d) ** -0.5),
        "cmp_w2_v": nrm(ks[19], (L, CMP_HIDDEN, d), CMP_HIDDEN ** -0.5),
        "w_out_rwkv": nrm(ks[20], (L, RWKV_WIDTH, D_MODEL), RWKV_WIDTH ** -0.5),
        "w_out_nsa": nrm(ks[21], (L, NSA_Q_WIDTH, D_MODEL), NSA_Q_WIDTH ** -0.5),
        "w_o": nrm(ks[22], (L, D_MODEL, D_MODEL), D_MODEL ** -0.5),
        "norm_mlp": 1.0 + nrm(ks[23], (L, D_MODEL), 0.02),
        "mlp_w_up": nrm(ks[24], (L, D_MODEL, D_FF), D_MODEL ** -0.5),
        "mlp_w_down": nrm(ks[25], (L, D_FF, D_MODEL), D_FF ** -0.5),
        "norm_final": 1.0 + nrm(ks[26], (D_MODEL,), 0.02),
    }


def reference(x, norm_mix, w_in, rwkv_mu, rwkv_w0, rwkv_w_up, rwkv_a0, rwkv_a_up, rwkv_g_up,
              rwkv_k_k, rwkv_k_a, rwkv_r_k, rwkv_lnx_w, rwkv_lnx_b,
              cmp_pe_k, cmp_w1_k, cmp_w2_k, cmp_pe_v, cmp_w1_v, cmp_w2_v,
              w_out_rwkv, w_out_nsa, w_o, norm_mlp, mlp_w_up, mlp_w_down, norm_final):
    offs = [int(o) for o in np.cumsum([RWKV_COLS, NSA_Q_WIDTH] + [NSA_KV_WIDTH] * 6 + [3 * NSA_HEADS, D_MODEL])]
    h = x
    for l in range(DEPTH):
        xn = rmsnorm(h, norm_mix[l])
        proj = xn @ w_in[l]
        z_rwkv, q, kc, vc, ks, vs, kw, vw, nsa_gate, gate_a, gate_b = jnp.split(proj, offs, axis=-1)
        y_a = rwkv7_time_mix(z_rwkv, rwkv_mu[l], rwkv_w0[l], rwkv_w_up[l], rwkv_a0[l], rwkv_a_up[l],
                             rwkv_g_up[l], rwkv_k_k[l], rwkv_k_a[l], rwkv_r_k[l], rwkv_lnx_w[l], rwkv_lnx_b[l])
        y_b = nsa_attention(q, kc, vc, ks, vs, kw, vw, nsa_gate, cmp_pe_k[l], cmp_w1_k[l], cmp_w2_k[l],
                            cmp_pe_v[l], cmp_w1_v[l], cmp_w2_v[l])
        mixed = jax.nn.sigmoid(gate_a) * (y_a @ w_out_rwkv[l]) + jax.nn.sigmoid(gate_b) * (y_b @ w_out_nsa[l])
        h = h + mixed @ w_o[l]
        hn = rmsnorm(h, norm_mlp[l])
        h = h + jnp.square(jax.nn.relu(hn @ mlp_w_up[l])) @ mlp_w_down[l]
    return rmsnorm(h, norm_final)
```

```cpp
#include <hip/hip_runtime.h>
#include <cstdio>
#include <cstdint>

#ifndef MK_ONE_LAUNCH
#define MK_ONE_LAUNCH 1
#endif

namespace pg8 {
#define PG8_LAS __attribute__((address_space(3)))
typedef unsigned short bf16_t;
typedef short bf16x8 __attribute__((ext_vector_type(8)));
typedef float f32x4 __attribute__((ext_vector_type(4)));
typedef unsigned u32x4 __attribute__((ext_vector_type(4)));
constexpr int BM = 256, BK = 64, HALF = 128, HTB = HALF * BK * 2  , STAGE_BYTES = 8 * HTB, NXCD = 8, WGM = 8;

__host__ __device__ __forceinline__ int lds_byte(int r, int c) { const int st = (r >> 4) * 2 + (c >> 5), rr = r & 15, cc = c & 31, ob = rr * 64 + cc * 2; return st * 1024 + (ob ^ (((ob >> 9) & 1) << 5)); }
__host__ __device__ __forceinline__ void stage_rc(int b, int& R, int& C) { const int st = b / 1024, sb = b % 1024, swz = sb ^ (((sb >> 9) & 1) << 5); R = (st >> 1) * 16 + swz / 64; C = (st & 1) * 32 + (swz % 64) / 2; }
__host__ __device__ __forceinline__ int perm32(int rho) { const int n = rho >> 4, i = rho & 15; return 8 * (i >> 2) + 4 * n + (i & 3); }

struct Unit { int pm, pn; };
struct Gemm { const bf16_t* A; const bf16_t* Bt; int M, N, K; };

struct StaticOrder {
    int nM, nN, nwg, G, c;
    __host__ __device__ void init(int M, int N, int G_, int c_) { nM = M / BM; nN = N / BM; nwg = nM * nN; G = G_; c = c_; }
    __host__ __device__ bool next(int i, Unit& u) const {
        const long L = (long)i * G + c; if (L >= nwg) return false;
        int wgid = (int)L; { const int q = nwg / NXCD, r = nwg % NXCD, xcd = wgid % NXCD, off = wgid / NXCD; wgid = (xcd < r ? xcd * (q + 1) : r * (q + 1) + (xcd - r) * q) + off; }
        const int nig = WGM * nN, gid = wgid / nig, fm = gid * WGM, gsz = (nM - fm) < WGM ? (nM - fm) : WGM;
        u.pm = fm + ((wgid % nig) % gsz); u.pn = (wgid % nig) / gsz; return true;
    }
    __device__ __forceinline__ void a_ready(const Unit&) const {}
    __device__ __forceinline__ void done(const Unit&) const {}
};

template <class Epi, class Sched, bool ALIGN_EPI = false, bool SP2 = false>
__device__ __forceinline__ void gemm_phase(PG8_LAS unsigned char* lds, const Gemm g, const Sched& S, const Epi& E, int wave_id_) {
    int tid_o_; asm volatile("v_mbcnt_lo_u32_b32 %0, -1, 0\n\tv_mbcnt_hi_u32_b32 %0, -1, %0" : "=v"(tid_o_)); tid_o_ += wave_id_ * 64;
    const int tid = tid_o_, wid = __builtin_amdgcn_readfirstlane(tid >> 6), lane = tid & 63, wr = wid >> 2, wc = wid & 3, fr = lane & 15, fq = lane >> 4;
    const int K = g.K, nt = K / BK;
    unsigned voffA[2], voffB[2];
#pragma unroll
    for (int i = 0; i < 2; ++i) { int R, C; stage_rc(tid * 16 + i * 8192, R, C); const int Rb = Epi::PERM ? ((R & ~31) + perm32(R & 31)) : R;
        voffA[i] = (unsigned)(R * K + C) * 2u; voffB[i] = (unsigned)(Rb * K + C) * 2u; }
    const size_t kstep = (size_t)(BK * 2);
    const size_t hstep = (size_t)HALF * K * 2;
    const size_t tstep = 2 * hstep;
    const unsigned ldsw = (unsigned)wid * 1024u;
    const int aoff = lds_byte(wr * 64 + fr, fq * 8), boff = lds_byte(wc * 32 + fr, fq * 8);
#define PG8_SA(b, h) (((b) * 2 + (h)) * HTB)
#define PG8_SB(b, h) ((4 + (b) * 2 + (h)) * HTB)
#define PG8_STAGE(bufoff, gbase, voff) do { _Pragma("unroll") for (int _i = 0; _i < 2; ++_i) \
        __builtin_amdgcn_global_load_lds((const unsigned*)((const char*)(gbase) + (voff)[_i]), (PG8_LAS unsigned*)(lds + (bufoff) + ldsw + _i * 8192), 16, 0, 0); } while (0)
#define PG8_LDA(dst, b, h) do { _Pragma("unroll") for (int m = 0; m < 4; ++m) _Pragma("unroll") for (int k = 0; k < 2; ++k) dst[m][k] = *(const PG8_LAS bf16x8*)(lds + PG8_SA(b, h) + aoff + m * 2048 + k * 1024); } while (0)
#define PG8_LDB(dst, b, h) do { _Pragma("unroll") for (int n = 0; n < 2; ++n) _Pragma("unroll") for (int k = 0; k < 2; ++k) dst[n][k] = *(const PG8_LAS bf16x8*)(lds + PG8_SB(b, h) + boff + n * 2048 + k * 1024); } while (0)
#define PG8_MMA(ai, bj, At, Bt) do { __builtin_amdgcn_s_setprio(1); _Pragma("unroll") for (int m = 0; m < 4; ++m) _Pragma("unroll") for (int n = 0; n < 2; ++n) _Pragma("unroll") for (int k = 0; k < 2; ++k) \
        acc[ai][bj][m][n] = __builtin_amdgcn_mfma_f32_16x16x32_bf16(Bt[n][k], At[m][k], acc[ai][bj][m][n], 0, 0, 0); __builtin_amdgcn_s_setprio(0); } while (0)
#define PG8_WAIT_V(n) asm volatile("s_waitcnt vmcnt(" #n ")" ::: "memory")
#define PG8_WAIT_L(n) asm volatile("s_waitcnt lgkmcnt(" #n ")" ::: "memory")
#define PG8_BAR __builtin_amdgcn_s_barrier()
#define PG8_SCHED __builtin_amdgcn_sched_barrier(0)
    Unit cur, nxt; int ui = 0;
    if (!S.next(0, cur)) return;
    f32x4 acc[2][2][4][2];
#pragma unroll
    for (int a = 0; a < 2; ++a)
#pragma unroll
        for (int b = 0; b < 2; ++b)
#pragma unroll
            for (int m = 0; m < 4; ++m)
#pragma unroll
                for (int n = 0; n < 2; ++n) acc[a][b][m][n] = (f32x4){0.f, 0.f, 0.f, 0.f};
    bf16x8 At[4][2], B0[2][2], B1[2][2];
    const char* cA = (const char*)g.A + (size_t)cur.pm * tstep; const char* cB = (const char*)g.Bt + (size_t)cur.pn * tstep;
    S.a_ready(cur);
    if constexpr (SP2) {
        PG8_STAGE(PG8_SB(0, 0), cB, voffB); PG8_STAGE(PG8_SB(0, 1), cB + hstep, voffB); PG8_STAGE(PG8_SA(0, 0), cA, voffA); PG8_STAGE(PG8_SA(0, 1), cA + hstep, voffA);
        if (wr == 1) PG8_BAR;
        PG8_WAIT_V(2); PG8_BAR;
        PG8_STAGE(PG8_SB(1, 0), cB + kstep, voffB); PG8_STAGE(PG8_SA(1, 0), cA + kstep, voffA); PG8_STAGE(PG8_SB(1, 1), cB + hstep + kstep, voffB);
        PG8_WAIT_V(6); PG8_BAR;
    } else {
        PG8_STAGE(PG8_SB(0, 0), cB, voffB); PG8_STAGE(PG8_SA(0, 0), cA, voffA); PG8_STAGE(PG8_SB(0, 1), cB + hstep, voffB); PG8_STAGE(PG8_SA(0, 1), cA + hstep, voffA);
        if (wr == 1) PG8_BAR;
        PG8_WAIT_V(4); PG8_BAR;
        PG8_STAGE(PG8_SB(1, 0), cB + kstep, voffB); PG8_STAGE(PG8_SA(1, 0), cA + kstep, voffA); PG8_STAGE(PG8_SB(1, 1), cB + hstep + kstep, voffB);
        PG8_WAIT_V(6); PG8_BAR;
    }
    for (;;) {
        const bool has_next = S.next(ui + 1, nxt);
        const char* nA = has_next ? (const char*)g.A + (size_t)nxt.pm * tstep : cA; const char* nB = has_next ? (const char*)g.Bt + (size_t)nxt.pn * tstep : cB;
        for (int t = 0; t < nt; t += 2) {
            const bool last = (t == nt - 2);
            const char* a1 = cA + (size_t)(t + 1) * kstep;
            const char* a2 = last ? nA : cA + (size_t)(t + 2) * kstep; const char* b2 = last ? nB : cB + (size_t)(t + 2) * kstep;
            const char* a3 = a2 + kstep; const char* b3 = b2 + kstep;
            if (last && has_next) S.a_ready(nxt);
            if constexpr (SP2) {
            PG8_LDB(B0, 0, 0); PG8_LDB(B1, 0, 1); PG8_SCHED; PG8_LDA(At, 0, 0); PG8_STAGE(PG8_SA(1, 1), a1 + hstep, voffA);
            PG8_WAIT_V(8); PG8_WAIT_L(0); PG8_BAR; PG8_MMA(0, 0, At, B0); PG8_MMA(0, 1, At, B1); PG8_BAR; PG8_SCHED;
            PG8_LDA(At, 0, 1); PG8_STAGE(PG8_SB(0, 0), b2, voffB); PG8_STAGE(PG8_SB(0, 1), b2 + hstep, voffB); PG8_STAGE(PG8_SA(0, 0), a2, voffA);
            PG8_WAIT_V(8); PG8_WAIT_L(0); PG8_BAR; PG8_MMA(1, 0, At, B0); PG8_MMA(1, 1, At, B1); PG8_BAR; PG8_SCHED;
            PG8_LDB(B0, 1, 0); PG8_LDB(B1, 1, 1); PG8_SCHED; PG8_LDA(At, 1, 0); PG8_STAGE(PG8_SA(0, 1), a2 + hstep, voffA);
            PG8_WAIT_V(8); PG8_WAIT_L(0); PG8_BAR; PG8_MMA(0, 0, At, B0); PG8_MMA(0, 1, At, B1); PG8_BAR; PG8_SCHED;
            PG8_LDA(At, 1, 1); PG8_STAGE(PG8_SB(1, 0), b3, voffB); PG8_STAGE(PG8_SB(1, 1), b3 + hstep, voffB); PG8_STAGE(PG8_SA(1, 0), a3, voffA);
            PG8_WAIT_V(8); PG8_WAIT_L(0); PG8_BAR; PG8_MMA(1, 0, At, B0); PG8_MMA(1, 1, At, B1); PG8_BAR; PG8_SCHED;
            } else {
            PG8_LDB(B0, 0, 0); PG8_SCHED; PG8_LDA(At, 0, 0); PG8_STAGE(PG8_SA(1, 1), a1 + hstep, voffA);
            PG8_WAIT_L(8); PG8_BAR; PG8_WAIT_L(0); PG8_MMA(0, 0, At, B0); PG8_BAR; PG8_SCHED;
            PG8_LDB(B1, 0, 1); PG8_STAGE(PG8_SB(0, 0), b2, voffB);
            PG8_BAR; PG8_WAIT_L(0); PG8_MMA(0, 1, At, B1); PG8_BAR;
            PG8_LDA(At, 0, 1); PG8_STAGE(PG8_SA(0, 0), a2, voffA);
            PG8_BAR; PG8_WAIT_L(0); PG8_MMA(1, 0, At, B0); PG8_BAR; PG8_SCHED;
            PG8_STAGE(PG8_SB(0, 1), b2 + hstep, voffB);
            PG8_WAIT_V(6); PG8_BAR; PG8_MMA(1, 1, At, B1); PG8_BAR;
            PG8_LDB(B0, 1, 0); PG8_SCHED; PG8_LDA(At, 1, 0); PG8_STAGE(PG8_SA(0, 1), a2 + hstep, voffA);
            PG8_WAIT_L(8); PG8_BAR; PG8_WAIT_L(0); PG8_MMA(0, 0, At, B0); PG8_BAR; PG8_SCHED;
            PG8_LDB(B1, 1, 1); PG8_STAGE(PG8_SB(1, 0), b3, voffB);
            PG8_BAR; PG8_WAIT_L(0); PG8_MMA(0, 1, At, B1); PG8_BAR;
            PG8_LDA(At, 1, 1); PG8_STAGE(PG8_SA(1, 0), a3, voffA);
            PG8_BAR; PG8_WAIT_L(0); PG8_MMA(1, 0, At, B0); PG8_BAR; PG8_SCHED;
            PG8_STAGE(PG8_SB(1, 1), b3 + hstep, voffB);
            PG8_WAIT_V(6); PG8_BAR; PG8_MMA(1, 1, At, B1); PG8_BAR;
            }
        }
        if constexpr (ALIGN_EPI) { if (wr == 0) PG8_BAR; }
        if constexpr (Epi::CHAIN) { if ((ui & 1) == 0) E.mid(acc, cur, wr, wc, fr, fq); else E(acc, cur, wr, wc, fr, fq); }
        else if constexpr (!Epi::AFTER_DRAIN) { E(acc, cur, wr, wc, fr, fq); S.done(cur); }
        if (!has_next) break;
        const bool zero_acc_ = !Epi::CHAIN || (ui & 1) == 1;
#pragma unroll
        for (int a = 0; a < 2; ++a)
#pragma unroll
            for (int b = 0; b < 2; ++b)
#pragma unroll
                for (int m = 0; m < 4; ++m)
#pragma unroll
                    for (int n = 0; n < 2; ++n) if (zero_acc_) acc[a][b][m][n] = (f32x4){0.f, 0.f, 0.f, 0.f};
        cur = nxt; cA = nA; cB = nB; ++ui;
        if constexpr (ALIGN_EPI) { if (wr == 1) PG8_BAR; }
    }
    PG8_WAIT_V(0);
    if constexpr (!ALIGN_EPI) { if (wr == 0) PG8_BAR; }
    PG8_BAR;
    if constexpr (Epi::AFTER_DRAIN) { E.fused(acc, cur, wr, wc, fr, fq, lds, wid, lane); S.done(cur); }
#undef PG8_SA
#undef PG8_SB
#undef PG8_STAGE
#undef PG8_LDA
#undef PG8_LDB
#undef PG8_MMA
#undef PG8_WAIT_V
#undef PG8_WAIT_L
#undef PG8_BAR
#undef PG8_SCHED
}
}

constexpr int NTOK = 8192, SEQ = 2048, DM = 2048, NB = 4;
constexpr int ZR_LD = 3520, ZN_LD = 2608, ZG_LD = 4096, INC = 10224, INCP = 10240;
constexpr int DFF = 8192;
constexpr int ZN_Q = 0, ZN_KC = 1024, ZN_VC = 1280, ZN_KS = 1536, ZN_VS = 1792, ZN_KW = 2048, ZN_VW = 2304, ZN_GATE = 2560;

typedef unsigned short bf16;
typedef short bf16x8 __attribute__((ext_vector_type(8)));
typedef float f32x4 __attribute__((ext_vector_type(4)));
typedef float f32x16 __attribute__((ext_vector_type(16)));
typedef unsigned u32x4 __attribute__((ext_vector_type(4)));
typedef unsigned u32x2 __attribute__((ext_vector_type(2)));
typedef short s16x4 __attribute__((ext_vector_type(4)));
#define GAS __attribute__((address_space(1)))
#define LAS __attribute__((address_space(3)))
typedef GAS unsigned gu32;

__device__ __forceinline__ float bf2f(unsigned u) { return __uint_as_float(u << 16); }
__device__ __forceinline__ unsigned f2bf(float f) { unsigned u = __float_as_uint(f); return (u + 0x7fffu + ((u >> 16) & 1u)) >> 16; }
__device__ __forceinline__ unsigned pk2(float lo, float hi) { return f2bf(lo) | (f2bf(hi) << 16); }
__device__ __forceinline__ u32x4 pack8(const f32x4 a, const f32x4 b) { u32x4 w; w.x = pk2(a[0], a[1]); w.y = pk2(a[2], a[3]); w.z = pk2(b[0], b[1]); w.w = pk2(b[2], b[3]); return w; }
__device__ __forceinline__ float sigmoidf_(float x) { return __builtin_amdgcn_rcpf(1.0f + __expf(-x)); }
__device__ __forceinline__ float wave_sum(float v) {
#pragma unroll
    for (int o = 1; o < 64; o <<= 1) v += __shfl_xor(v, o);
    return v;
}

constexpr size_t MiB = 1u << 20;
constexpr size_t WS_CTL = 0, CTL_ZERO_BYTES = 1 * MiB;
constexpr size_t CTL_ROWSQ1 = 256 * 1024, CTL_ROWSQ2 = 320 * 1024;
constexpr size_t WS_LORAT = 1 * MiB, WS_W1T = 3 * MiB, WS_WOUTT = 5 * MiB, WS_WOT = 13 * MiB, WS_MISC = 21 * MiB;
constexpr size_t WS_WINT = 22 * MiB, WS_XN = 62 * MiB;
constexpr size_t WS_LORA = 22 * MiB;
constexpr size_t WS_SALL = 22 * MiB;
constexpr size_t WS_MIXED = 22 * MiB;
constexpr size_t WS_H1B = 54 * MiB;
constexpr size_t WS_QC = 70 * MiB, WS_YH = 86 * MiB;
constexpr size_t WS_ZR = 102 * MiB, WS_ZN = 158 * MiB, WS_ZG = 202 * MiB;
constexpr size_t WS_UPT = 102 * MiB, WS_DOWNT = 134 * MiB;
constexpr size_t WS_ACT = 166 * MiB;
constexpr size_t WS_A2 = 266 * MiB, WS_AG = 278 * MiB, WS_HPART = 294 * MiB;
constexpr size_t WS_BON = 266 * MiB;
constexpr size_t WS_YAB = 282 * MiB;
constexpr size_t WS_KCV = 314 * MiB;
constexpr size_t WS_END = 315 * MiB;
constexpr int CW_TMO = 0, CW_BAR = 4096;

constexpr int RING_BYTES = 131072, LDSCTL_OFF = RING_BYTES, MISC_OFF = LDSCTL_OFF + 320, LDS_BYTES = 147456;

__device__ __forceinline__ void tile_decode(int wgid, int nwg, int nM, int nN, int& pm, int& pn) {
    const int q = nwg / 8, r = nwg % 8, xcd = wgid % 8, off = wgid / 8;
    wgid = (xcd < r ? xcd * (q + 1) : r * (q + 1) + (xcd - r) * q) + off;
    const int nig = 8 * nN, gid = wgid / nig, fm = gid * 8, gsz = (nM - fm) < 8 ? (nM - fm) : 8;
    pm = fm + ((wgid % nig) % gsz); pn = (wgid % nig) / gsz;
}
template <int nM, int nN, int nblk>
struct CatOrder {
    int G, c;
    __device__ void init(int G_, int c_) { G = G_; c = c_; }
    __device__ bool next(int i, pg8::Unit& u) const {
        constexpr int nbase = nM * nN;
        const int L = i * G + c; if (L >= nbase * nblk) return false;
        const int blk = L / nbase, w = L % nbase; int pm, pn; tile_decode(w, nbase, nM, nN, pm, pn);
        u.pm = pm + blk * nM; u.pn = pn + blk * nN; return true;
    }
    __device__ __forceinline__ void a_ready(const pg8::Unit&) const {}
    __device__ __forceinline__ void done(const pg8::Unit&) const {}
};
template <int nM, int nN>
struct PairOrder {
    int G, c;
    __device__ void init(int G_, int c_) { G = G_; c = c_; }
    __device__ bool next(int i, pg8::Unit& u) const {
        constexpr int nbase = nM * nN;
        const int L = (i >> 1) * G + c; if (L >= nbase) return false;
        int pm, pn; tile_decode(L, nbase, nM, nN, pm, pn);
        u.pm = pm + (i & 1) * nM; u.pn = pn + (i & 1) * nN; return true;
    }
    __device__ __forceinline__ void a_ready(const pg8::Unit&) const {}
    __device__ __forceinline__ void done(const pg8::Unit&) const {}
};

typedef const f32x4 (&AccC)[2][2][4][2];
typedef f32x4 (&AccM)[2][2][4][2];

struct EpiProj {
    static constexpr bool PERM = true, AFTER_DRAIN = false, CHAIN = false;
    bf16 *ZR, *ZN, *ZG;
    __device__ __forceinline__ void operator()(AccC acc, const pg8::Unit& u, int wr, int wc, int fr, int fq) const {
        const int row0 = u.pm * 256 + wr * 64 + fr;
#pragma unroll
        for (int bj = 0; bj < 2; ++bj) {
            const int c = u.pn * 256 + bj * 128 + wc * 32 + 8 * fq;
            bf16* p; int ld;
            if (c < 3520) { p = ZR + c; ld = ZR_LD; } else if (c < 6128) { p = ZN + (c - 3520); ld = ZN_LD; } else if (c < INC) { p = ZG + (c - 6128); ld = ZG_LD; } else continue;
#pragma unroll
            for (int ai = 0; ai < 2; ++ai)
#pragma unroll
                for (int m = 0; m < 4; ++m) { const int row = row0 + ai * 128 + m * 16; *(u32x4*)(p + (size_t)row * ld) = pack8(acc[ai][bj][m][0], acc[ai][bj][m][1]); }
        }
    }
};
struct EpiLora {
    static constexpr bool PERM = true, AFTER_DRAIN = false, CHAIN = false;
    bf16* LORA; const float* w0; const float* a0;
    template <int WHICH> __device__ __forceinline__ void run(AccC acc, const pg8::Unit& u, int wr, int wc, int fr, int fq) const {
        const int row0 = (u.pm - 32 * WHICH) * 256 + wr * 64 + fr;
        const float* bp = WHICH == 0 ? w0 : a0;
#pragma unroll
        for (int bj = 0; bj < 2; ++bj) {
            const int col = (u.pn & 3) * 256 + bj * 128 + wc * 32 + 8 * fq;
            f32x4 bias0 = (f32x4){0.f, 0.f, 0.f, 0.f}, bias1 = bias0;
            if (WHICH < 2) { bias0 = *(const f32x4*)(bp + col); bias1 = *(const f32x4*)(bp + col + 4); }
            bf16* p = LORA + ((size_t)WHICH * NTOK + row0) * 1024 + col;
#pragma unroll
            for (int ai = 0; ai < 2; ++ai)
#pragma unroll
                for (int m = 0; m < 4; ++m) {
                    f32x4 v0 = acc[ai][bj][m][0] + bias0, v1 = acc[ai][bj][m][1] + bias1;
                    if (WHICH < 2) {
#pragma unroll
                        for (int e = 0; e < 4; ++e) { v0[e] = sigmoidf_(v0[e]); v1[e] = sigmoidf_(v1[e]); }
                        if (WHICH == 0) { v0 = v0 * -0.6065306597f; v1 = v1 * -0.6065306597f; }
                    }
                    *(u32x4*)(p + (size_t)(ai * 128 + m * 16) * 1024) = pack8(v0, v1);
                }
        }
    }
    __device__ __forceinline__ void operator()(AccC acc, const pg8::Unit& u, int wr, int wc, int fr, int fq) const {
        const int which = u.pn >> 2;
#ifdef LORA_PROBE
        run<2>(acc, u, wr, wc, fr, fq);
#else
        if (which == 0) run<0>(acc, u, wr, wc, fr, fq); else if (which == 1) run<1>(acc, u, wr, wc, fr, fq); else run<2>(acc, u, wr, wc, fr, fq);
#endif
    }
};
struct EpiHpart {
    static constexpr bool PERM = false, AFTER_DRAIN = false, CHAIN = false;
    float* C;
    __device__ __forceinline__ void operator()(AccC acc, const pg8::Unit& u, int wr, int wc, int fr, int fq) const {
        const int row0 = u.pm * 256 + wr * 64 + fr, col0 = wc * 32 + 4 * fq;
#pragma unroll
        for (int ai = 0; ai < 2; ++ai)
#pragma unroll
            for (int m = 0; m < 4; ++m) { float* rowp = C + (size_t)(row0 + ai * 128 + m * 16) * 256 + col0;
#pragma unroll
                for (int bj = 0; bj < 2; ++bj)
#pragma unroll
                    for (int n = 0; n < 2; ++n) *(f32x4*)(rowp + bj * 128 + n * 16) = acc[ai][bj][m][n]; }
    }
};
struct EpiMerge {
    static constexpr bool PERM = true, AFTER_DRAIN = false, CHAIN = false;
    const bf16* ZG; bf16* MIXED;
    __device__ __forceinline__ void operator()(AccC acc, const pg8::Unit& u, int wr, int wc, int fr, int fq) const {
        const int second = u.pm >= 32 ? 1 : 0;
        const int row0 = (u.pm - 32 * second) * 256 + wr * 64 + fr, colb = (u.pn - 8 * second) * 256 + wc * 32 + 8 * fq;
#pragma unroll
        for (int ai = 0; ai < 2; ++ai)
#pragma unroll
            for (int m = 0; m < 4; ++m) {
                const size_t row = (size_t)(row0 + ai * 128 + m * 16);
#pragma unroll
                for (int bj = 0; bj < 2; ++bj) {
                    const u32x4 gt = *(const u32x4*)(ZG + row * ZG_LD + 2048 * second + colb + bj * 128);
                    u32x4 prev = (u32x4){0u, 0u, 0u, 0u};
                    if (second) prev = *(const u32x4*)(MIXED + row * DM + colb + bj * 128);
                    float v[8];
#pragma unroll
                    for (int e = 0; e < 8; ++e) {
                        const float gv = (e & 1) ? bf2f(gt[e >> 1] >> 16) : bf2f(gt[e >> 1] & 0xffffu), pv = (e & 1) ? bf2f(prev[e >> 1] >> 16) : bf2f(prev[e >> 1] & 0xffffu);
                        v[e] = pv + acc[ai][bj][m][e >> 2][e & 3] * sigmoidf_(gv);
                    }
                    u32x4 w; w.x = pk2(v[0], v[1]); w.y = pk2(v[2], v[3]); w.z = pk2(v[4], v[5]); w.w = pk2(v[6], v[7]);
                    *(u32x4*)(MIXED + row * DM + colb + bj * 128) = w;
                }
                asm volatile("" ::: "memory");
            }
    }
};
struct EpiWo {
    static constexpr bool PERM = false, AFTER_DRAIN = false, CHAIN = false;
    const float* X; float* H1; bf16* H1B; float* rowsq;
    __device__ __forceinline__ void operator()(AccC acc, const pg8::Unit& u, int wr, int wc, int fr, int fq) const {
        const int row0 = u.pm * 256 + wr * 64 + fr, col0 = u.pn * 256 + wc * 32 + 4 * fq;
#pragma unroll
        for (int ai = 0; ai < 2; ++ai)
#pragma unroll
            for (int m = 0; m < 4; ++m) {
                const int row = row0 + ai * 128 + m * 16; const size_t off = (size_t)row * DM + col0; float ss = 0.f;
#pragma unroll
                for (int bj = 0; bj < 2; ++bj)
#pragma unroll
                    for (int n = 0; n < 2; ++n) {
                        const f32x4 h = *(const f32x4*)(X + off + bj * 128 + n * 16) + acc[ai][bj][m][n];
                        *(f32x4*)(H1 + off + bj * 128 + n * 16) = h;
                        u32x2 w; w.x = pk2(h[0], h[1]); w.y = pk2(h[2], h[3]); *(u32x2*)(H1B + off + bj * 128 + n * 16) = w;
                        ss += (h[0] * h[0] + h[1] * h[1]) + (h[2] * h[2] + h[3] * h[3]);
                    }
                ss += __shfl_xor(ss, 16); ss += __shfl_xor(ss, 32);
                if (fq == 0) atomicAdd(rowsq + row, ss);
            }
    }
};
struct EpiUp {
    static constexpr bool PERM = true, AFTER_DRAIN = false, CHAIN = false;
    const float* rowsq; bf16* ACT;
    __device__ __forceinline__ void operator()(AccC acc, const pg8::Unit& u, int wr, int wc, int fr, int fq) const {
        const int row0 = u.pm * 256 + wr * 64 + fr;
#pragma unroll
        for (int ai = 0; ai < 2; ++ai)
#pragma unroll
            for (int m = 0; m < 4; ++m) {
                const int row = row0 + ai * 128 + m * 16;
                const float rs = rsqrtf(__hip_atomic_load(rowsq + row, __ATOMIC_RELAXED, __HIP_MEMORY_SCOPE_AGENT) * (1.0f / DM) + 1e-5f);
#pragma unroll
                for (int bj = 0; bj < 2; ++bj) {
                    const int col = u.pn * 256 + bj * 128 + wc * 32 + 8 * fq; float v[8];
#pragma unroll
                    for (int e = 0; e < 8; ++e) { const float x = fmaxf(acc[ai][bj][m][e >> 2][e & 3] * rs, 0.f); v[e] = x * x; }
                    u32x4 w; w.x = pk2(v[0], v[1]); w.y = pk2(v[2], v[3]); w.z = pk2(v[4], v[5]); w.w = pk2(v[6], v[7]);
                    *(u32x4*)(ACT + (size_t)row * DFF + col) = w;
                }
            }
    }
};
struct EpiDown {
    static constexpr bool PERM = false, AFTER_DRAIN = false, CHAIN = false;
    float* H; float* rowsq;
    __device__ __forceinline__ void operator()(AccC acc, const pg8::Unit& u, int wr, int wc, int fr, int fq) const {
        const int row0 = u.pm * 256 + wr * 64 + fr, col0 = u.pn * 256 + wc * 32 + 4 * fq;
#pragma unroll
        for (int ai = 0; ai < 2; ++ai)
#pragma unroll
            for (int m = 0; m < 4; ++m) {
                const int row = row0 + ai * 128 + m * 16; const size_t off = (size_t)row * DM + col0; float ss = 0.f;
#pragma unroll
                for (int bj = 0; bj < 2; ++bj)
#pragma unroll
                    for (int n = 0; n < 2; ++n) {
                        const f32x4 h = *(const f32x4*)(H + off + bj * 128 + n * 16) + acc[ai][bj][m][n];
                        *(f32x4*)(H + off + bj * 128 + n * 16) = h;
                        ss += (h[0] * h[0] + h[1] * h[1]) + (h[2] * h[2] + h[3] * h[3]);
                    }
                ss += __shfl_xor(ss, 16); ss += __shfl_xor(ss, 32);
                if (fq == 0) atomicAdd(rowsq + row, ss);
            }
    }
};
#define XB_TMO      128
#define XB_XCNT(j)  (256  + 64 * (j))
#define XB_XSUB(j)  (1280 + 64 * (j))
#define XB_XGEN(j)  (2304 + 64 * (j))
#define XB_TOP      3328
#define XB_TOPGEN   3392
#define XCD_BAR_WORDS 3456
#define XB_SPIN_CAP (1u << 18)

__device__ __forceinline__ unsigned xb_ld(unsigned* p)              { return __hip_atomic_load(p, __ATOMIC_RELAXED, __HIP_MEMORY_SCOPE_AGENT); }
__device__ __forceinline__ unsigned xb_add(unsigned* p, unsigned v) { return __hip_atomic_fetch_add(p, v, __ATOMIC_RELAXED, __HIP_MEMORY_SCOPE_AGENT); }
__device__ __forceinline__ unsigned xb_xcc_id() { return (unsigned)__builtin_amdgcn_s_getreg((3 << 11) | 20) & 0xFu; }
#define XB_SPIN(cond, bar) do { unsigned _sp = 0; while (cond) { __builtin_amdgcn_s_sleep(1); \
    if ((++_sp & 255u) == 0u) { if (xb_ld(&(bar)[XB_TMO])) break; if (_sp > XB_SPIN_CAP) { atomicAdd(&(bar)[XB_TMO], 1u); break; } } } } while (0)

struct XcdBarrier {
    unsigned* bar; unsigned x;
    volatile LAS unsigned* st;
};

__device__ __forceinline__ XcdBarrier xcd_barrier_post(unsigned* bar, volatile LAS unsigned* st, int tid_) {
    XcdBarrier b; b.bar = bar; b.x = xb_xcc_id(); b.st = st;
    if (tid_ == 0) (void)xb_add(&bar[XB_XCNT(b.x)], 1u);
    return b;
}
__device__ __forceinline__ void xcd_barrier_complete(unsigned* bar, unsigned x, unsigned& nloc, unsigned& nx) {
    const unsigned G = gridDim.x * gridDim.y * gridDim.z;
    unsigned sum, cnt, mine, sp = 0u;
    for (;;) {
        sum = 0u; cnt = 0u; mine = 0u;
#pragma unroll
        for (unsigned j = 0; j < 16; ++j) { const unsigned c = xb_ld(&bar[XB_XCNT(j)]); sum += c; cnt += (c > 0u) ? 1u : 0u; mine = (j == x) ? c : mine; }
        if (sum == G) break;
        __builtin_amdgcn_s_sleep(1);
        if ((++sp & 255u) == 0u) { if (xb_ld(&bar[XB_TMO])) break; if (sp > XB_SPIN_CAP) { atomicAdd(&bar[XB_TMO], 1u); break; } }
    }
    nloc = mine > 0u ? mine : 1u; nx = cnt > 0u ? cnt : 1u;
}

__device__ __forceinline__ void xcd_barrier(const XcdBarrier& b, int tid_) {
    asm volatile("s_waitcnt vmcnt(0)" ::: "memory");
    __syncthreads();
    if (tid_ == 0) {
        unsigned* bar = b.bar;
        __builtin_amdgcn_s_waitcnt(0);
        unsigned nloc = b.st[0], nx = b.st[1];
        if (nloc == 0u) { xcd_barrier_complete(bar, b.x, nloc, nx); b.st[0] = nloc; b.st[1] = nx; }
        const unsigned old = xb_add(&bar[XB_XSUB(b.x)], 1u);
        const unsigned gen = old / nloc;
        if (old + 1u == (gen + 1u) * nloc) {
            __builtin_amdgcn_fence(__ATOMIC_RELEASE, "agent");
            asm volatile("s_waitcnt vmcnt(0)" ::: "memory");
            const unsigned og = xb_add(&bar[XB_TOP], 1u);
            const unsigned tg = og / nx;
            if (og + 1u == (tg + 1u) * nx) xb_add(&bar[XB_TOPGEN], 1u);
            else XB_SPIN(xb_ld(&bar[XB_TOPGEN]) == tg, bar);
            __builtin_amdgcn_fence(__ATOMIC_ACQUIRE, "agent");
            xb_add(&bar[XB_XGEN(b.x)], 1u);
            asm volatile("s_waitcnt vmcnt(0)" ::: "memory");
        } else {
            XB_SPIN(xb_ld(&bar[XB_XGEN(b.x)]) == gen, bar);
            __builtin_amdgcn_fence(__ATOMIC_ACQUIRE, "agent");
            asm volatile("s_waitcnt vmcnt(0)" ::: "memory");
        }
    }
    __syncthreads();
}

struct Args { const float* in[27]; float* out; unsigned char* ws; int ph_lo, ph_hi, li, pad; };
struct Frame {
    LAS unsigned char* lds;
    int tid, lane, wave, vcu, G;
    const float* const* in;
};
#define LDS_WAIT() asm volatile("s_waitcnt lgkmcnt(0)" ::: "memory")

__device__ __forceinline__ void cvt_item(const float* W, int ldw, int Kv, int Nv, int k0, int n0, bf16* dst, int ldd, const float* ksc, LAS float* scr, int lane) {
#pragma unroll 8
    for (int i = 0; i < 32; ++i) {
        const int kk = 2 * i + (lane >> 5), k = k0 + kk, n = n0 + (lane & 31);
        float v = 0.f;
        if (k < Kv && n < Nv) { v = W[(size_t)k * ldw + n]; if (ksc) v *= ksc[k]; }
        scr[kk * 33 + (lane & 31)] = v;
    }
    LDS_WAIT(); asm volatile("" ::: "memory");
    const int c = lane & 7;
#pragma unroll
    for (int j = 0; j < 4; ++j) {
        const int n = (lane >> 3) + 8 * j; const LAS float* s = scr + (8 * c) * 33 + n;
        u32x4 o; o.x = pk2(s[0 * 33], s[1 * 33]); o.y = pk2(s[2 * 33], s[3 * 33]); o.z = pk2(s[4 * 33], s[5 * 33]); o.w = pk2(s[6 * 33], s[7 * 33]);
        *(u32x4*)(dst + (size_t)(n0 + n) * ldd + k0 + 8 * c) = o;
    }
    LDS_WAIT(); asm volatile("" ::: "memory");
}
#define CVT_MAT(W_, ldw_, Kv_, Nv_, nkb_, nnb_, dst_, ldd_, ksc_) { const int cnt_ = (nkb_) * (nnb_); if (r < cnt_) { cvt_item(W_, ldw_, Kv_, Nv_, 64 * (r / (nnb_)), 32 * (r % (nnb_)), dst_, ldd_, ksc_, scr, F.lane); continue; } r -= cnt_; }

__device__ __forceinline__ void ph0_prologue(const Frame& F, const Args& A) {
    unsigned char* ws = A.ws;
    LAS float* scr = (LAS float*)(F.lds + F.wave * 16384);
    const int gw = F.vcu * 8 + F.wave, NGW = F.G * 8;
    bf16* WinT = (bf16*)(ws + WS_WINT); bf16* LoraT = (bf16*)(ws + WS_LORAT); bf16* W1T = (bf16*)(ws + WS_W1T); bf16* WoutT = (bf16*)(ws + WS_WOUTT); bf16* WoT = (bf16*)(ws + WS_WOT);
    constexpr int N_WIN = 32 * 320, N_LORA = 4 * 32, N_W1 = 8 * 8, N_WOUT = 16 * 64, N_WO = 32 * 64;
    constexpr int NITEMS = N_WIN + 3 * N_LORA + 8 * N_W1 + 2 * N_WOUT + N_WO;
    for (int it = gw; it < NITEMS; it += NGW) {
        int r = it;
        CVT_MAT(A.in[2], INC, 2048, INC, 32, 320, WinT, 2048, nullptr)
        CVT_MAT(A.in[5], 1024, 96, 1024, 4, 32, LoraT, 256, nullptr)
        CVT_MAT(A.in[7], 1024, 96, 1024, 4, 32, LoraT + 1024 * 256, 256, nullptr)
        CVT_MAT(A.in[8], 1024, 256, 1024, 4, 32, LoraT + 2 * 1024 * 256, 256, nullptr)
#pragma unroll
        for (int ks = 0; ks < 4; ++ks) {
            CVT_MAT(A.in[15] + (size_t)ks * 512 * 256, 256, 512, 256, 8, 8, W1T + (size_t)((ks * 2 + 0) * 256) * 512, 512, nullptr)
            CVT_MAT(A.in[18] + (size_t)ks * 512 * 256, 256, 512, 256, 8, 8, W1T + (size_t)((ks * 2 + 1) * 256) * 512, 512, nullptr)
        }
        CVT_MAT(A.in[20], 2048, 1024, 2048, 16, 64, WoutT, 1024, nullptr)
        CVT_MAT(A.in[21], 2048, 1024, 2048, 16, 64, WoutT + (size_t)2048 * 1024, 1024, nullptr)
        CVT_MAT(A.in[22], 2048, 2048, 2048, 32, 64, WoT, 2048, nullptr)
    }
    {
        const float* x = A.in[0]; const float* nm = A.in[1]; bf16* XN = (bf16*)(ws + WS_XN);
        for (int m = gw; m < NTOK; m += NGW) {
            const f32x4* xr = (const f32x4*)(x + (size_t)m * DM) + F.lane; f32x4 v[8]; float s = 0.f;
#pragma unroll
            for (int j = 0; j < 8; ++j) { v[j] = xr[64 * j]; s += (v[j][0] * v[j][0] + v[j][1] * v[j][1]) + (v[j][2] * v[j][2] + v[j][3] * v[j][3]); }
            const float rstd = rsqrtf(wave_sum(s) * (1.f / DM) + 1e-5f);
#pragma unroll
            for (int j = 0; j < 8; ++j) {
                const f32x4 g = *((const f32x4*)nm + F.lane + 64 * j); u32x2 w;
                w.x = pk2(v[j][0] * rstd * g[0], v[j][1] * rstd * g[1]); w.y = pk2(v[j][2] * rstd * g[2], v[j][3] * rstd * g[3]);
                *((u32x2*)(XN + (size_t)m * DM) + F.lane + 64 * j) = w;
            }
        }
    }
    if (gw < 8) {
        const int which = gw >> 2, c = (gw & 3) * 64 + F.lane;
        const float* pe = which ? A.in[17] : A.in[14]; const float* w1 = which ? A.in[18] : A.in[15];
        float s0 = 0.f, s1 = 0.f, s2 = 0.f, s3 = 0.f;
        for (int k = 0; k < 2048; k += 4) { s0 += pe[k] * w1[(size_t)k * 256 + c]; s1 += pe[k + 1] * w1[(size_t)(k + 1) * 256 + c]; s2 += pe[k + 2] * w1[(size_t)(k + 2) * 256 + c]; s3 += pe[k + 3] * w1[(size_t)(k + 3) * 256 + c]; }
        ((float*)(ws + WS_MISC))[which * 256 + c] = (s0 + s1) + (s2 + s3);
    }
}
__device__ __forceinline__ void ph_cvt_mlp(const Frame& F, const Args& A) {
    unsigned char* ws = A.ws;
    LAS float* scr = (LAS float*)(F.lds + F.wave * 16384);
    const int gw = F.vcu * 8 + F.wave, NGW = F.G * 8;
    bf16* UpT = (bf16*)(ws + WS_UPT); bf16* DownT = (bf16*)(ws + WS_DOWNT);
    constexpr int NITEMS = 32 * 256 + 128 * 64;
    for (int it = gw; it < NITEMS; it += NGW) {
        int r = it;
        CVT_MAT(A.in[24], DFF, 2048, DFF, 32, 256, UpT, 2048, A.in[23])
        CVT_MAT(A.in[25], 2048, DFF, 2048, 128, 64, DownT, DFF, nullptr)
    }
}

__device__ __forceinline__ void ph2_build(const Frame& F, const Args& A) {
    unsigned char* ws = A.ws;
    const bf16* ZR = (const bf16*)(ws + WS_ZR); const bf16* ZN = (const bf16*)(ws + WS_ZN);
    bf16* A2 = (bf16*)(ws + WS_A2); bf16* Ag = (bf16*)(ws + WS_AG);
    const float* mu = A.in[3];
    const int gt = F.vcu * 512 + F.tid, NGT = F.G * 512;
    for (int idx = gt; idx < 3 * NTOK * 32; idx += NGT) {
        const int blk = idx / (NTOK * 32), row = (idx >> 5) & (NTOK - 1), c0 = (idx & 31) * 8;
        u32x4 o = (u32x4){0u, 0u, 0u, 0u};
        if (blk == 2 || c0 < 96) {
            const int col = (blk == 0 ? 3072 : (blk == 1 ? 3168 : 3264)) + c0;
            const u32x4 z = *(const u32x4*)(ZR + (size_t)row * ZR_LD + col);
            u32x4 zp = (u32x4){0u, 0u, 0u, 0u};
            if ((row & (SEQ - 1)) != 0) zp = *(const u32x4*)(ZR + (size_t)(row - 1) * ZR_LD + col);
            float v[8];
#pragma unroll
            for (int e = 0; e < 8; ++e) {
                const float a = (e & 1) ? bf2f(z[e >> 1] >> 16) : bf2f(z[e >> 1] & 0xffffu), p = (e & 1) ? bf2f(zp[e >> 1] >> 16) : bf2f(zp[e >> 1] & 0xffffu);
                const float s = a + (p - a) * mu[col + e];
                v[e] = blk == 0 ? tanhf(s) : (blk == 1 ? s : sigmoidf_(s));
            }
            o.x = pk2(v[0], v[1]); o.y = pk2(v[2], v[3]); o.z = pk2(v[4], v[5]); o.w = pk2(v[6], v[7]);
        }
        *(u32x4*)(A2 + (size_t)idx * 8) = o;
    }
    for (int idx = gt; idx < 8 * 2048 * 64; idx += NGT) {
        const int blk = idx >> 17, r = (idx >> 6) & 2047, cg = idx & 63, ks = blk >> 1, which = blk & 1;
        u32x4 o = (u32x4){0u, 0u, 0u, 0u};
        if (r < 2032) {
            const int kf = ks * 512 + cg * 8, l = kf >> 6, dd = kf & 63, b = r / 508, rem = r - b * 508, n = rem >> 2, g = rem & 3;
            o = *(const u32x4*)(ZN + (size_t)(b * SEQ + 16 * n + l) * ZN_LD + (which ? ZN_VC : ZN_KC) + g * 64 + dd);
        }
        *(u32x4*)(Ag + (size_t)idx * 8) = o;
    }
}

__device__ __forceinline__ void cmp_finish_unit(const Frame& F, const Args& A, int u) {
    unsigned char* ws = A.ws;
    const float* Hp = (const float*)(ws + WS_HPART); const float* bias1 = (const float*)(ws + WS_MISC);
    bf16* KCV = (bf16*)(ws + WS_KCV);
    const int which = u >> 6, rb = u & 63;
    const float* w2 = which ? A.in[19] : A.in[16];
    LAS float* h = (LAS float*)F.lds;
    __syncthreads();
    for (int idx = F.tid; idx < 32 * 256; idx += 512) {
        const int r = idx >> 8, c = idx & 255; float v = bias1[which * 256 + c];
#pragma unroll
        for (int ks = 0; ks < 4; ++ks) v += Hp[((size_t)((ks * 2 + which) * 2048) + 32 * rb + r) * 256 + c];
        const float t = 0.7978845608028654f * (v + 0.044715f * v * v * v);
        h[r * 257 + c] = 0.5f * v * (1.f + tanhf(t));
    }
    __syncthreads();
    const int r = F.tid >> 4, dq = F.tid & 15;
    f32x4 acc = (f32x4){0.f, 0.f, 0.f, 0.f};
    for (int c = 0; c < 256; ++c) { const float hv = h[r * 257 + c]; const f32x4 w = *(const f32x4*)(w2 + c * 64 + 4 * dq); acc += hv * w; }
    const int R = 32 * rb + r;
    if (R < 2032) {
        const int b = R / 508, rem = R - b * 508, n = rem >> 2, g = rem & 3;
        u32x2 w; w.x = pk2(acc[0], acc[1]); w.y = pk2(acc[2], acc[3]);
        *(u32x2*)(KCV + (size_t)which * (16 * 128 * 64) + ((size_t)(b * 4 + g) * 128 + n) * 64 + 4 * dq) = w;
    }
    if (u == 0 && F.tid < 512) {
        for (int i = F.tid; i < 2 * 16 * 32; i += 512) { const int wh = i / 512, bg = (i >> 5) & 15, c2 = i & 31; *(unsigned*)(KCV + (size_t)wh * (16 * 128 * 64) + ((size_t)bg * 128 + 127) * 64 + 2 * c2) = 0u; }
    }
}

__device__ __forceinline__ void scan_chunk(const Frame& F, const Args& A, int ch, LAS float* wl) {
    unsigned char* ws = A.ws;
    const bf16* ZR = (const bf16*)(ws + WS_ZR); const bf16* LD = (const bf16*)(ws + WS_LORA); const bf16* AA = LD + (size_t)NTOK * 1024;
    bf16* BON = (bf16*)(ws + WS_BON); bf16* QC = (bf16*)(ws + WS_QC); bf16* YH = (bf16*)(ws + WS_YH);
    float* AC = A.out; float* GC = A.out + (size_t)2048 * 4096;
    const int lane = F.lane, bh = ch >> 5, c = ch & 31, b = bh >> 4, h = bh & 15, hj = h * 64 + lane;
    const float* mu = A.in[3];
    const float mu_r = mu[hj], mu_k = mu[1024 + hj], mu_v = mu[2048 + hj];
    const float kkw = A.in[9][hj], kaw = A.in[10][hj], rkw = A.in[11][hj];
    float SA[64], SG[64];
    int lane_o = lane; asm volatile("" : "+v"(lane_o));
#pragma unroll
    for (int j = 0; j < 64; ++j) { SA[j] = (j == lane_o) ? 1.f : 0.f; SG[j] = 0.f; }
    const size_t row0 = (size_t)b * SEQ + c * 64;
    float pr = 0.f, pk = 0.f, pv = 0.f;
    if (c != 0) { const bf16* zp = ZR + (row0 - 1) * ZR_LD + hj; pr = bf2f(zp[0]); pk = bf2f(zp[1024]); pv = bf2f(zp[2048]); }
    for (int sg = 0; sg < 8; ++sg) {
#pragma unroll 2
        for (int s = 0; s < 8; ++s) {
            const size_t row = row0 + sg * 8 + s;
            const bf16* zp = ZR + row * ZR_LD + hj;
            const float zr = bf2f(zp[0]), zk = bf2f(zp[1024]), zv = bf2f(zp[2048]);
            const float r = zr + (pr - zr) * mu_r, k = zk + (pk - zk) * mu_k, v = zv + (pv - zv) * mu_v;
            pr = zr; pk = zk; pv = zv;
            const float w = __expf(bf2f(LD[row * 1024 + hj])), a = bf2f(AA[row * 1024 + hj]);
            const float kkr = k * kkw; const float n2 = wave_sum(kkr * kkr); const float kk = kkr * rsqrtf(fmaxf(n2, 1e-24f));
            const float kp = k * (1.f + (a - 1.f) * kaw), bb = kk * a; const float rkr = wave_sum(r * kp * rkw);
            LAS float* o = wl + s * 384 + lane;
            o[0] = -kk; o[64] = w; o[128] = bb; o[192] = kp; o[256] = r; o[320] = v;
            BON[row * 1024 + hj] = (bf16)f2bf(rkr * v);
        }
        for (int s = 0; s < 8; ++s) {
            const LAS f32x4* p = (const LAS f32x4*)(wl + s * 384);
            const float vi = wl[s * 384 + 320 + lane];
            float a0 = 0.f, a1 = 0.f, a2 = 0.f, a3 = 0.f, g0 = 0.f, g1 = 0.f, g2 = 0.f, g3 = 0.f;
#pragma unroll
            for (int j4 = 0; j4 < 16; ++j4) {
                const f32x4 nk = p[j4];
                a0 += SA[4 * j4] * nk[0]; a1 += SA[4 * j4 + 1] * nk[1]; a2 += SA[4 * j4 + 2] * nk[2]; a3 += SA[4 * j4 + 3] * nk[3];
                g0 += SG[4 * j4] * nk[0]; g1 += SG[4 * j4 + 1] * nk[1]; g2 += SG[4 * j4 + 2] * nk[2]; g3 += SG[4 * j4 + 3] * nk[3];
                if ((j4 & 3) == 3) asm volatile("" ::: "memory");
            }
            const float saA = (a0 + a1) + (a2 + a3), saG = (g0 + g1) + (g2 + g3);
            float ya0 = 0.f, ya1 = 0.f, yg0 = 0.f, yg1 = 0.f;
#pragma unroll
            for (int j4 = 0; j4 < 16; ++j4) {
                const f32x4 w4 = p[16 + j4], b4 = p[32 + j4], k4 = p[48 + j4], r4 = p[64 + j4];
#pragma unroll
                for (int e = 0; e < 4; ++e) {
                    const int j = 4 * j4 + e;
                    SA[j] = SA[j] * w4[e] + saA * b4[e];
                    SG[j] = SG[j] * w4[e] + saG * b4[e] + vi * k4[e];
                    if (e & 1) { ya1 += SA[j] * r4[e]; yg1 += SG[j] * r4[e]; } else { ya0 += SA[j] * r4[e]; yg0 += SG[j] * r4[e]; }
                }
                if (j4 & 1) asm volatile("" ::: "memory");
            }
            const size_t oidx = (size_t)ch * 4096 + (sg * 8 + s) * 64 + lane;
            QC[oidx] = (bf16)f2bf(ya0 + ya1); YH[oidx] = (bf16)f2bf(yg0 + yg1);
        }
    }
    float* ap = AC + (size_t)ch * 4096 + lane * 64; float* gp = GC + (size_t)ch * 4096 + lane * 64;
#pragma unroll
    for (int j4 = 0; j4 < 16; ++j4) {
        *(f32x4*)(ap + 4 * j4) = (f32x4){SA[4 * j4], SA[4 * j4 + 1], SA[4 * j4 + 2], SA[4 * j4 + 3]};
        *(f32x4*)(gp + 4 * j4) = (f32x4){SG[4 * j4], SG[4 * j4 + 1], SG[4 * j4 + 2], SG[4 * j4 + 3]};
    }
}

__device__ __forceinline__ void r3_unit(const Frame& F, const Args& A, int bh, int rg) {
    unsigned char* ws = A.ws;
    const float* AC = A.out; const float* GC = A.out + (size_t)2048 * 4096; float* SALL = (float*)(ws + WS_SALL);
    LAS float* Sl = (LAS float*)F.lds;
    const int lane = F.lane, lr = lane & 15, lq = lane >> 4, ct = F.wave;
    __syncthreads();
    for (int i = F.tid; i < 2 * 16 * 66; i += 512) Sl[i] = 0.f;
    __syncthreads();
    int cur = 0;
    for (int c = 0; c < 31; ++c) {
        const int ch = bh * 32 + c;
        if (ct < 4) {
            const float* Ap = AC + (size_t)ch * 4096; const float* Gp = GC + (size_t)ch * 4096;
            float Bf[16];
#pragma unroll
            for (int kk = 0; kk < 16; ++kk) Bf[kk] = Ap[(4 * kk + lq) * 64 + 16 * ct + lr];
            f32x4 acc;
#pragma unroll
            for (int rg_ = 0; rg_ < 4; ++rg_) acc[rg_] = Gp[(16 * rg + 4 * lq + rg_) * 64 + 16 * ct + lr];
            const LAS float* Sc = Sl + cur * (16 * 66);
#pragma unroll
            for (int kk = 0; kk < 16; ++kk) acc = __builtin_amdgcn_mfma_f32_16x16x4f32(Sc[lr * 66 + 4 * kk + lq], Bf[kk], acc, 0, 0, 0);
            LAS float* Sn = Sl + (cur ^ 1) * (16 * 66);
            float* So = SALL + (size_t)(ch + 1) * 4096;
#pragma unroll
            for (int rg_ = 0; rg_ < 4; ++rg_) { Sn[(4 * lq + rg_) * 66 + 16 * ct + lr] = acc[rg_]; So[(16 * rg + 4 * lq + rg_) * 64 + 16 * ct + lr] = acc[rg_]; }
        }
        __syncthreads();
        cur ^= 1;
    }
}

__device__ __forceinline__ void r4_pair(const Frame& F, const Args& A, int chbase) {
    unsigned char* ws = A.ws;
    const bf16* QC = (const bf16*)(ws + WS_QC); const bf16* YH = (const bf16*)(ws + WS_YH); const float* SALL = (const float*)(ws + WS_SALL);
    const bf16* BON = (const bf16*)(ws + WS_BON); const bf16* GG = (const bf16*)(ws + WS_LORA) + (size_t)2 * NTOK * 1024; bf16* YA = (bf16*)(ws + WS_YAB);
    const float* lnw = A.in[12]; const float* lnb = A.in[13];
    const int lane = F.lane, lr = lane & 15, lq = lane >> 4, half = F.wave >> 2, st = F.wave & 3;
    const int ch = chbase + half, c = ch & 31, bh = ch >> 5, b = bh >> 4, h = bh & 15;
    LAS float* Qf = (LAS float*)F.lds + half * (2 * 64 * 66); LAS float* Sf = Qf + 64 * 66;
    __syncthreads();
    for (int idx = F.tid & 255; idx < 4096; idx += 256) {
        const int s = idx >> 6, k = idx & 63;
        Qf[s * 66 + k] = bf2f(QC[(size_t)ch * 4096 + idx]);
        Sf[s * 66 + k] = (c == 0) ? 0.f : SALL[(size_t)ch * 4096 + idx];
    }
    __syncthreads();
    f32x4 acc[4];
#pragma unroll
    for (int it = 0; it < 4; ++it)
#pragma unroll
        for (int rg_ = 0; rg_ < 4; ++rg_) acc[it][rg_] = bf2f(YH[(size_t)ch * 4096 + (16 * st + 4 * lq + rg_) * 64 + 16 * it + lr]);
#pragma unroll
    for (int kk = 0; kk < 16; ++kk) {
        const float a = Qf[(16 * st + lr) * 66 + 4 * kk + lq];
#pragma unroll
        for (int it = 0; it < 4; ++it) acc[it] = __builtin_amdgcn_mfma_f32_16x16x4f32(a, Sf[(16 * it + lr) * 66 + 4 * kk + lq], acc[it], 0, 0, 0);
    }
#pragma unroll
    for (int rg_ = 0; rg_ < 4; ++rg_) {
        float s = (acc[0][rg_] + acc[1][rg_]) + (acc[2][rg_] + acc[3][rg_]);
        s += __shfl_xor(s, 1); s += __shfl_xor(s, 2); s += __shfl_xor(s, 4); s += __shfl_xor(s, 8);
        const float mean = s * (1.f / 64.f);
        float d[4], q = 0.f;
#pragma unroll
        for (int it = 0; it < 4; ++it) { d[it] = acc[it][rg_] - mean; q += d[it] * d[it]; }
        q += __shfl_xor(q, 1); q += __shfl_xor(q, 2); q += __shfl_xor(q, 4); q += __shfl_xor(q, 8);
        const float rstd = rsqrtf(q * (1.f / 64.f) + 64e-5f);
        const size_t row = (size_t)b * SEQ + c * 64 + 16 * st + 4 * lq + rg_;
#pragma unroll
        for (int it = 0; it < 4; ++it) {
            const int col = h * 64 + 16 * it + lr;
            float y = d[it] * rstd * lnw[col] + lnb[col];
            y = (y + bf2f(BON[row * 1024 + col])) * bf2f(GG[row * 1024 + col]);
            YA[row * 1024 + col] = (bf16)f2bf(y);
        }
    }
}

__device__ __forceinline__ int crow(int r, int hi) { return (r & 3) + 8 * (r >> 2) + 4 * hi; }
constexpr int NSA_KS = 0, NSA_VS = 8192, NSA_WSF = 16384, NSA_IMP = 17408, NSA_MASK = 17408 + 64 * 33 * 4, NSA_ANY = NSA_MASK + 256, NSA_QF = 32768, NSA_OST = 65536;

__device__ __forceinline__ u32x4 nsa_ldk(const bf16* Kg, int ld, int key0, int tid) { return *(const u32x4*)(Kg + (size_t)(key0 + (tid & 63)) * ld + (tid >> 6) * 8); }
__device__ __forceinline__ u32x4 nsa_ldv(const bf16* Vg, int ld, int key0, int tid) { const int w8 = tid >> 6, lane = tid & 63; return *(const u32x4*)(Vg + (size_t)(key0 + 16 * (w8 & 3) + (lane >> 2)) * ld + (w8 >> 2) * 32 + (lane & 3) * 8); }
__device__ __forceinline__ s16x4 nsa_vtr(const LAS unsigned char* p) { typedef short v4i16_t __attribute__((ext_vector_type(4))); return __builtin_bit_cast(s16x4, __builtin_amdgcn_ds_read_tr16_b64_v4i16((LAS v4i16_t*)p)); }

__device__ __forceinline__ void nsa_qk(f32x16& p0, f32x16& p1, const LAS unsigned char* ks, const LAS unsigned char* qf, int r32, int hi) {
    const LAS unsigned char* kb = ks + hi * 1024 + r32 * 16;
    p0 = (f32x16){}; p1 = (f32x16){};
#pragma unroll
    for (int d0 = 0; d0 < 4; ++d0) {
        const bf16x8 b0 = *(const LAS bf16x8*)(kb + d0 * 2048), b1 = *(const LAS bf16x8*)(kb + d0 * 2048 + 512), q = *(const LAS bf16x8*)(qf + d0 * 1024);
        p0 = __builtin_amdgcn_mfma_f32_32x32x16_bf16(b0, q, p0, 0, 0, 0);
        p1 = __builtin_amdgcn_mfma_f32_32x32x16_bf16(b1, q, p1, 0, 0, 0);
    }
}
__device__ __forceinline__ void nsa_pv(f32x16 (&o)[2], const f32x16& p0, const f32x16& p1, const LAS unsigned char* vs, int lane, int hi) {
    bf16x8 pa[4];
#pragma unroll
    for (int k = 0; k < 4; ++k) {
        u32x4 w;
#pragma unroll
        for (int e = 0; e < 4; ++e) { const int r = (k & 1) * 8 + 2 * e; w[e] = (k < 2) ? pk2(p0[r], p0[r + 1]) : pk2(p1[r], p1[r + 1]); }
        pa[k] = __builtin_bit_cast(bf16x8, w);
    }
    const LAS unsigned char* vb = vs + ((lane >> 4) & 1) * 32 + (lane & 3) * 8 + (4 * hi + ((lane & 15) >> 2)) * 64;
#pragma unroll
    for (int dh = 0; dh < 2; ++dh)
#pragma unroll
        for (int k = 0; k < 4; ++k) {
            const s16x4 lo = nsa_vtr(vb + dh * 4096 + k * 1024), hi4 = nsa_vtr(vb + dh * 4096 + k * 1024 + 512);
            const bf16x8 vf = (bf16x8){lo[0], lo[1], lo[2], lo[3], hi4[0], hi4[1], hi4[2], hi4[3]};
            o[dh] = __builtin_amdgcn_mfma_f32_32x32x16_bf16(pa[k], vf, o[dh], 0, 0, 0);
        }
}
template <bool INIT>
__device__ __forceinline__ void nsa_accum(LAS float* ost, const f32x16 (&o)[2], float f, LAS float* wsf, int lane, int r32, int hi) {
    if (hi == 0) wsf[r32] = f;
    LDS_WAIT(); asm volatile("" ::: "memory");
#pragma unroll
    for (int r = 0; r < 16; ++r) {
        const float a = wsf[crow(r, hi)];
        if (INIT) { ost[r * 64 + lane] = a * o[0][r]; ost[(16 + r) * 64 + lane] = a * o[1][r]; }
        else { ost[r * 64 + lane] += a * o[0][r]; ost[(16 + r) * 64 + lane] += a * o[1][r]; }
    }
    LDS_WAIT(); asm volatile("" ::: "memory");
}

template <int MODE>
__device__ __forceinline__ void nsa_branch(const bf16* Kg, const bf16* Vg, int jlo, int jhi, unsigned anymask, unsigned mymask, int t, float slope,
                                           LAS unsigned char* lds, int tid, int lane, f32x16 (&o)[2], float& l_out) {
    const int r32 = lane & 31, hi = lane >> 5, wid = tid >> 6;
    LAS float* wsf = (LAS float*)(lds + NSA_WSF) + wid * 32;
    const LAS unsigned char* qf = lds + NSA_QF + wid * 4096 + lane * 16;
    float m = -1e30f, l = 0.f; o[0] = (f32x16){}; o[1] = (f32x16){};
    int j = jlo;
    if (MODE == 2) while (j <= jhi && !((anymask >> j) & 1u)) ++j;
    if (j > jhi) { l_out = 0.f; return; }
    u32x4 kreg = nsa_ldk(Kg, ZN_LD, 64 * j, tid), vreg = nsa_ldv(Vg, ZN_LD, 64 * j, tid);
    __syncthreads();
    *(LAS u32x4*)(lds + NSA_KS + tid * 16) = kreg; *(LAS u32x4*)(lds + NSA_VS + tid * 16) = vreg;
    __syncthreads();
    for (;;) {
        int jn = j + 1;
        if (MODE == 2) while (jn <= jhi && !((anymask >> jn) & 1u)) ++jn;
        const bool hn = jn <= jhi;
        if (hn) { kreg = nsa_ldk(Kg, ZN_LD, 64 * jn, tid); vreg = nsa_ldv(Vg, ZN_LD, 64 * jn, tid); }
        f32x16 p0, p1;
        nsa_qk(p0, p1, lds + NSA_KS, qf, r32, hi);
        const bool sel = (MODE == 2) ? (((mymask >> j) & 1u) != 0u) : true;
        const int pos0 = 64 * j;
        float mx = -1e30f;
#pragma unroll
        for (int r = 0; r < 16; ++r) {
            const int d0 = t - (pos0 + crow(r, hi)), d1 = d0 - 32;
            const bool v0 = sel && d0 >= 0 && (MODE == 1 ? d0 < 512 : true), v1 = sel && d1 >= 0 && (MODE == 1 ? d1 < 512 : true);
            const float s0 = v0 ? (p0[r] * 0.125f - slope * (float)d0) : -1e30f, s1 = v1 ? (p1[r] * 0.125f - slope * (float)d1) : -1e30f;
            p0[r] = s0; p1[r] = s1; mx = fmaxf(mx, fmaxf(s0, s1));
        }
        mx = fmaxf(mx, __shfl_xor(mx, 32));
        const float mn = fmaxf(m, mx), alpha = __expf(m - mn);
        float ps = 0.f;
#pragma unroll
        for (int r = 0; r < 16; ++r) {
            const float e0 = (p0[r] > -0.5e30f) ? __expf(p0[r] - mn) : 0.f, e1 = (p1[r] > -0.5e30f) ? __expf(p1[r] - mn) : 0.f;
            p0[r] = e0; p1[r] = e1; ps += e0 + e1;
        }
        ps += __shfl_xor(ps, 32);
        l = l * alpha + ps; m = mn;
        if (__any(alpha != 1.f)) {
            if (hi == 0) wsf[r32] = alpha;
            LDS_WAIT(); asm volatile("" ::: "memory");
#pragma unroll
            for (int r = 0; r < 16; ++r) { const float a = wsf[crow(r, hi)]; o[0][r] *= a; o[1][r] *= a; }
            LDS_WAIT(); asm volatile("" ::: "memory");
        }
        nsa_pv(o, p0, p1, lds + NSA_VS, lane, hi);
        __syncthreads();
        if (!hn) break;
        *(LAS u32x4*)(lds + NSA_KS + tid * 16) = kreg; *(LAS u32x4*)(lds + NSA_VS + tid * 16) = vreg;
        __syncthreads();
        j = jn;
    }
    l_out = l;
}

__device__ __forceinline__ void nsa_unit(const Frame& F, const Args& A, int b, int g, int qb) {
    unsigned char* ws = A.ws;
    const bf16* ZN = (const bf16*)(ws + WS_ZN); const bf16* KC = (const bf16*)(ws + WS_KCV); const bf16* VC = KC + 16 * 128 * 64; bf16* YB = (bf16*)(ws + WS_YAB) + (size_t)NTOK * 1024;
    LAS unsigned char* lds = F.lds;
    int lane_o = F.lane; asm volatile("" : "+v"(lane_o));
    const int wid = F.wave, lane = lane_o, tid = wid * 64 + lane, r32 = lane & 31, hi = lane >> 5, hg = r32 >> 3, ti = r32 & 7;
    const int tok = wid * 8 + ti, t = qb * 64 + tok, h = g * 4 + hg;
    const size_t row = (size_t)b * SEQ + t;
    const float slope = exp2f(-0.5f * (float)(h + 1));
    LAS float* wsf = (LAS float*)(lds + NSA_WSF) + wid * 32;
    LAS float* IMP = (LAS float*)(lds + NSA_IMP); LAS unsigned* MASK = (LAS unsigned*)(lds + NSA_MASK); LAS unsigned* ANYW = (LAS unsigned*)(lds + NSA_ANY);
    LAS unsigned char* qf = lds + NSA_QF + wid * 4096 + lane * 16;
    LAS float* ost = (LAS float*)(lds + NSA_OST) + wid * 2048;
    __syncthreads();
#pragma unroll
    for (int d0 = 0; d0 < 4; ++d0) *(LAS bf16x8*)(qf + d0 * 1024) = *(const bf16x8*)(ZN + row * ZN_LD + ZN_Q + h * 64 + d0 * 16 + hi * 8);
    const float gcmp = sigmoidf_(bf2f(ZN[row * ZN_LD + ZN_GATE + h])), gslc = sigmoidf_(bf2f(ZN[row * ZN_LD + ZN_GATE + 16 + h])), gwin = sigmoidf_(bf2f(ZN[row * ZN_LD + ZN_GATE + 32 + h]));
    {
        const bf16* KCb = KC + (size_t)(b * 4 + g) * 128 * 64; const bf16* VCb = VC + (size_t)(b * 4 + g) * 128 * 64;
        __syncthreads();
        *(LAS u32x4*)(lds + NSA_KS + tid * 16) = nsa_ldk(KCb, 64, 0, tid); *(LAS u32x4*)(lds + NSA_VS + tid * 16) = nsa_ldk(KCb, 64, 64, tid);
        __syncthreads();
        f32x16 a0, a1, b0, b1;
        nsa_qk(a0, a1, lds + NSA_KS, qf, r32, hi); nsa_qk(b0, b1, lds + NSA_VS, qf, r32, hi);
        {
            const u32x4 v0r = nsa_ldv(VCb, 64, 0, tid), v1r = nsa_ldv(VCb, 64, 64, tid);
            __syncthreads();
            *(LAS u32x4*)(lds + NSA_KS + tid * 16) = v0r; *(LAS u32x4*)(lds + NSA_VS + tid * 16) = v1r;
        }
        float mx = -1e30f;
#pragma unroll
        for (int r = 0; r < 16; ++r) {
            const int n = crow(r, hi);
            const int d00 = t - (16 * n + 31), d01 = d00 - 512, d10 = d00 - 1024, d11 = d00 - 1536;
            a0[r] = d00 >= 0 ? (a0[r] * 0.125f - slope * (float)d00) : -1e30f; a1[r] = d01 >= 0 ? (a1[r] * 0.125f - slope * (float)d01) : -1e30f;
            b0[r] = d10 >= 0 ? (b0[r] * 0.125f - slope * (float)d10) : -1e30f; b1[r] = d11 >= 0 ? (b1[r] * 0.125f - slope * (float)d11) : -1e30f;
            mx = fmaxf(fmaxf(mx, fmaxf(a0[r], a1[r])), fmaxf(b0[r], b1[r]));
        }
        mx = fmaxf(mx, __shfl_xor(mx, 32));
        float ps = 0.f;
#pragma unroll
        for (int r = 0; r < 16; ++r) {
            a0[r] = (a0[r] > -0.5e30f) ? __expf(a0[r] - mx) : 0.f; a1[r] = (a1[r] > -0.5e30f) ? __expf(a1[r] - mx) : 0.f;
            b0[r] = (b0[r] > -0.5e30f) ? __expf(b0[r] - mx) : 0.f; b1[r] = (b1[r] > -0.5e30f) ? __expf(b1[r] - mx) : 0.f;
            ps += (a0[r] + a1[r]) + (b0[r] + b1[r]);
        }
        ps += __shfl_xor(ps, 32);
        const float inv = 1.f / fmaxf(ps, 1e-30f);
#pragma unroll
        for (int r = 0; r < 16; ++r) { a0[r] *= inv; a1[r] *= inv; b0[r] *= inv; b1[r] *= inv; }
        float cprev = 0.f;
#pragma unroll
        for (int kk = 0; kk < 16; ++kk) {
            const int k = kk & 3, X = (kk >> 2) & 1, T = kk >> 3;
            float x0, x1, x2, x3;
            if (T == 0 && X == 0) { x0 = a0[4 * k]; x1 = a0[4 * k + 1]; x2 = a0[4 * k + 2]; x3 = a0[4 * k + 3]; }
            else if (T == 0) { x0 = a1[4 * k]; x1 = a1[4 * k + 1]; x2 = a1[4 * k + 2]; x3 = a1[4 * k + 3]; }
            else if (X == 0) { x0 = b0[4 * k]; x1 = b0[4 * k + 1]; x2 = b0[4 * k + 2]; x3 = b0[4 * k + 3]; }
            else { x0 = b1[4 * k]; x1 = b1[4 * k + 1]; x2 = b1[4 * k + 2]; x3 = b1[4 * k + 3]; }
            float av = (x0 + x1) + (x2 + 0.5f * x3), cv = 0.5f * x3;
            av += __shfl_xor(av, 8); av += __shfl_xor(av, 16); cv += __shfl_xor(cv, 8); cv += __shfl_xor(cv, 16);
            const float cp = __shfl_xor(cv, 32);
            const float impj = av + (hi ? cp : cprev);
            cprev = cp;
            if (hg == 0) IMP[tok * 33 + 2 * kk + hi] = impj;
        }
        __syncthreads();
        f32x16 oc[2]; oc[0] = (f32x16){}; oc[1] = (f32x16){};
        nsa_pv(oc, a0, a1, lds + NSA_KS, lane, hi); nsa_pv(oc, b0, b1, lds + NSA_VS, lane, hi);
        nsa_accum<true>(ost, oc, gcmp, wsf, lane, r32, hi);
        {
            int tid_o = tid; asm volatile("" : "+v"(tid_o));
            const int tk = tid_o >> 3, jq = tid_o & 7; unsigned bits = 0u;
            float sc[32];
#pragma unroll
            for (int jj = 0; jj < 32; ++jj) sc[jj] = (jj > qb) ? -1e30f : ((jj == 0 || jj == qb || jj == qb - 1) ? 1e30f : IMP[tk * 33 + jj]);
#pragma unroll
            for (int e = 0; e < 4; ++e) {
                const int j = jq * 4 + e;
                const float sj = (j > qb) ? -1e30f : ((j == 0 || j == qb || j == qb - 1) ? 1e30f : IMP[tk * 33 + j]);
                int cnt = 0;
#pragma unroll
                for (int jj = 0; jj < 32; ++jj) cnt += (sc[jj] > sj || (sc[jj] == sj && jj < j)) ? 1 : 0;
                if (cnt < 16 && sj > -0.5e30f) bits |= 1u << j;
            }
            bits |= __shfl_xor(bits, 1); bits |= __shfl_xor(bits, 2); bits |= __shfl_xor(bits, 4);
            if (jq == 0) MASK[tk] = bits;
        }
        __syncthreads();
        if (tid < 64) { unsigned v = MASK[tid]; v |= __shfl_xor(v, 1); v |= __shfl_xor(v, 2); v |= __shfl_xor(v, 4); v |= __shfl_xor(v, 8); v |= __shfl_xor(v, 16); v |= __shfl_xor(v, 32); if (tid == 0) ANYW[0] = v; }
        __syncthreads();
    }
    f32x16 o[2];
    const unsigned mymask = MASK[tok], anymask = ANYW[0];
    float lb;
#ifndef NSA_NO_WIN
    {
        const bf16* Kg = ZN + (size_t)b * SEQ * ZN_LD + ZN_KW + g * 64; const bf16* Vg = ZN + (size_t)b * SEQ * ZN_LD + ZN_VW + g * 64;
        nsa_branch<1>(Kg, Vg, qb >= 8 ? qb - 8 : 0, qb, 0u, 0u, t, slope, lds, tid, lane, o, lb);
        nsa_accum<false>(ost, o, gwin / fmaxf(lb, 1e-30f), wsf, lane, r32, hi);
    }
#endif
#ifndef NSA_NO_SEL
    {
        const bf16* Kg = ZN + (size_t)b * SEQ * ZN_LD + ZN_KS + g * 64; const bf16* Vg = ZN + (size_t)b * SEQ * ZN_LD + ZN_VS + g * 64;
        nsa_branch<2>(Kg, Vg, 0, qb, anymask, mymask, t, slope, lds, tid, lane, o, lb);
        nsa_accum<false>(ost, o, gslc / fmaxf(lb, 1e-30f), wsf, lane, r32, hi);
    }
#endif
    {
        int lane_s = lane; asm volatile("" : "+v"(lane_s));
        const int his = lane_s >> 5;
#pragma unroll
        for (int r = 0; r < 16; ++r) {
            const int q = crow(r, his), tq = qb * 64 + wid * 8 + (q & 7), hq = g * 4 + (q >> 3);
            bf16* dst = YB + ((size_t)b * SEQ + tq) * 1024 + hq * 64 + (lane_s & 31);
            dst[0] = (bf16)f2bf(ost[r * 64 + lane_s]); dst[32] = (bf16)f2bf(ost[(16 + r) * 64 + lane_s]);
        }
    }
}

constexpr int N_PHASES = 12;
template <int PHM> __global__ void __launch_bounds__(512, 2) mega_fwd(Args args) {
    extern __shared__ __attribute__((aligned(16))) unsigned char lds_raw[];
    Frame F;
    F.lds = (LAS unsigned char*)lds_raw;
    F.tid = threadIdx.x; F.lane = F.tid & 63; F.wave = __builtin_amdgcn_readfirstlane(F.tid >> 6);
    F.G = gridDim.x; { const int bx = blockIdx.x; F.vcu = (F.G % 8 == 0) ? (bx % 8) * (F.G / 8) + bx / 8 : bx; }
    F.in = nullptr;
    unsigned char* ws = args.ws;
    volatile LAS unsigned* MISC = (volatile LAS unsigned*)(F.lds + MISC_OFF);
    for (int u = F.tid; u < (LDS_BYTES - LDSCTL_OFF) / 4; u += 512) ((LAS unsigned*)(F.lds + LDSCTL_OFF))[u] = 0u;
    __syncthreads();
#if MK_ONE_LAUNCH
    XcdBarrier bar = xcd_barrier_post((unsigned*)(ws + WS_CTL) + CW_BAR, MISC + 8, F.tid);
#define GRID_BAR() do { PHASE_FRAME(); xcd_barrier(bar, Fp.tid); } while (0)
#else
#define GRID_BAR() do { } while (0)
#endif
    const int lo = args.ph_lo, hi = args.ph_hi;
#define PHASE_FRAME() Frame Fp = F; asm volatile("v_mbcnt_lo_u32_b32 %0, -1, 0\n\tv_mbcnt_hi_u32_b32 %0, -1, %0" : "=v"(Fp.lane)); asm volatile("" : "+s"(Fp.wave), "+s"(Fp.vcu)); Fp.tid = Fp.wave * 64 + Fp.lane
#define IN(k) (((PHM >> (k)) & 1) && lo <= (k) && (k) < hi)
#define SEAM(k) do { if (IN(k) && IN((k) + 1)) GRID_BAR(); } while (0)

    bf16* ZR = (bf16*)(ws + WS_ZR); bf16* ZN = (bf16*)(ws + WS_ZN); bf16* ZG = (bf16*)(ws + WS_ZG);
    float* rowsq1 = (float*)(ws + WS_CTL + CTL_ROWSQ1); float* rowsq2 = (float*)(ws + WS_CTL + CTL_ROWSQ2);

    if (IN(0)) { PHASE_FRAME(); ph0_prologue(Fp, args); }
    SEAM(0);
    if (IN(1)) {
        pg8::Gemm g{(const pg8::bf16_t*)(ws + WS_XN), (const pg8::bf16_t*)(ws + WS_WINT), NTOK, INCP, 2048};
        pg8::StaticOrder S; S.init(NTOK, INCP, F.G, (int)blockIdx.x);
        EpiProj E{ZR, ZN, ZG};
        pg8::gemm_phase<EpiProj, pg8::StaticOrder, true, true>(F.lds, g, S, E, F.wave);
    }
    SEAM(1);
    if (IN(2)) { PHASE_FRAME(); ph2_build(Fp, args); }
    SEAM(2);
    if (IN(3)) {
#ifndef NO_LORAGEMM
        {
            int kl = 256; asm volatile("" : "+s"(kl));
            pg8::Gemm g{(const pg8::bf16_t*)(ws + WS_A2), (const pg8::bf16_t*)(ws + WS_LORAT), 3 * NTOK, 3 * 1024, kl};
            CatOrder<32, 4, 3> S; S.init(F.G, (int)blockIdx.x);
            EpiLora E{(bf16*)(ws + WS_LORA), args.in[4], args.in[6]};
            pg8::gemm_phase<EpiLora, CatOrder<32, 4, 3>, true, true>(F.lds, g, S, E, F.wave);
        }
#endif
#ifndef NO_CMPGEMM
        {
            pg8::Gemm g{(const pg8::bf16_t*)(ws + WS_AG), (const pg8::bf16_t*)(ws + WS_W1T), 8 * 2048, 8 * 256, 512};
            int c2 = (int)((blockIdx.x + 64) % F.G); float* hp = (float*)(ws + WS_HPART);
            asm volatile("" : "+s"(c2), "+s"(hp));
            CatOrder<8, 1, 8> S; S.init(F.G, c2);
            EpiHpart E{hp};
            pg8::gemm_phase<EpiHpart, CatOrder<8, 1, 8>, true, true>(F.lds, g, S, E, F.wave);
        }
#endif
    }
    SEAM(3);
    if (IN(4)) {
        { PHASE_FRAME(); for (int u = Fp.vcu; u < 128; u += Fp.G) cmp_finish_unit(Fp, args, u); }
        __syncthreads();
        { PHASE_FRAME(); LAS float* wl = (LAS float*)(Fp.lds + Fp.wave * 12288);
          for (int ch = Fp.vcu * 8 + Fp.wave; ch < 2048; ch += Fp.G * 8) scan_chunk(Fp, args, ch, wl); }
    }
    SEAM(4);
    if (IN(5)) {
#ifndef NO_R3
        { PHASE_FRAME(); for (int u = Fp.vcu; u < 256; u += Fp.G) r3_unit(Fp, args, u >> 2, u & 3); }
#endif
        __syncthreads();
        PHASE_FRAME();
        for (int p = Fp.vcu; p < 256; p += Fp.G) {
            const int bg = p >> 4, s = p & 15;
#ifndef NO_NSA
#pragma unroll 1
            for (int k2 = 0; k2 < 2; ++k2) nsa_unit(Fp, args, bg >> 2, bg & 3, k2 ? s : 31 - s);
#endif
        }
    }
    SEAM(5);
    if (IN(6)) {
        { PHASE_FRAME(); for (int cp = Fp.vcu; cp < 1024; cp += Fp.G) r4_pair(Fp, args, 2 * cp); }
        __syncthreads();
        { PHASE_FRAME(); ph_cvt_mlp(Fp, args); }
    }
    SEAM(6);
    if (IN(7)) {
        pg8::Gemm g{(const pg8::bf16_t*)(ws + WS_YAB), (const pg8::bf16_t*)(ws + WS_WOUTT), 2 * NTOK, 2 * 2048, 1024};
        PairOrder<32, 8> S; S.init(F.G, (int)blockIdx.x);
        EpiMerge E{ZG, (bf16*)(ws + WS_MIXED)};
        pg8::gemm_phase<EpiMerge, PairOrder<32, 8>, false, true>(F.lds, g, S, E, F.wave);
    }
    SEAM(7);
    if (IN(8)) {
        pg8::Gemm g{(const pg8::bf16_t*)(ws + WS_MIXED), (const pg8::bf16_t*)(ws + WS_WOT), NTOK, 2048, 2048};
        pg8::StaticOrder S; S.init(NTOK, 2048, F.G, (int)blockIdx.x);
        EpiWo E{args.in[0], args.out, (bf16*)(ws + WS_H1B), rowsq1};
        pg8::gemm_phase<EpiWo, pg8::StaticOrder, false, true>(F.lds, g, S, E, F.wave);
    }
    SEAM(8);
    if (IN(9)) {
        pg8::Gemm g{(const pg8::bf16_t*)(ws + WS_H1B), (const pg8::bf16_t*)(ws + WS_UPT), NTOK, DFF, 2048};
        pg8::StaticOrder S; S.init(NTOK, DFF, F.G, (int)blockIdx.x);
        EpiUp E{rowsq1, (bf16*)(ws + WS_ACT)};
        pg8::gemm_phase<EpiUp, pg8::StaticOrder, true, true>(F.lds, g, S, E, F.wave);
    }
    SEAM(9);
    if (IN(10)) {
        pg8::Gemm g{(const pg8::bf16_t*)(ws + WS_ACT), (const pg8::bf16_t*)(ws + WS_DOWNT), NTOK, 2048, DFF};
        pg8::StaticOrder S; S.init(NTOK, 2048, F.G, (int)blockIdx.x);
        EpiDown E{args.out, rowsq2};
        pg8::gemm_phase<EpiDown, pg8::StaticOrder, false, true>(F.lds, g, S, E, F.wave);
    }
    SEAM(10);
    if (IN(11)) {
        PHASE_FRAME();
        const float* nf = args.in[26];
        const int gw = Fp.vcu * 8 + Fp.wave, NGW = Fp.G * 8;
        for (int m = gw; m < NTOK; m += NGW) {
            const float rs = rsqrtf(__hip_atomic_load(rowsq2 + m, __ATOMIC_RELAXED, __HIP_MEMORY_SCOPE_AGENT) * (1.f / DM) + 1e-5f);
            f32x4* o = (f32x4*)(args.out + (size_t)m * DM) + Fp.lane;
#pragma unroll
            for (int j = 0; j < 8; ++j) { const f32x4 g = *((const f32x4*)nf + Fp.lane + 64 * j); f32x4 v = o[64 * j]; v = v * rs * g; o[64 * j] = v; }
        }
    }
#undef IN
#undef SEAM
}

typedef void (*kern_t)(Args);
extern "C" void kernel_launch(void* const* d_in, const int* in_sizes, int n_in, void* d_out, int out_size, void* d_ws, size_t ws_size, hipStream_t stream) {
    static int grid = 0;
#if MK_ONE_LAUNCH
    static const kern_t kerns[1] = { mega_fwd<0xFFF> };
    constexpr int NK = 1;
#else
    static const kern_t kerns[12] = { mega_fwd<1>, mega_fwd<2>, mega_fwd<4>, mega_fwd<8>, mega_fwd<16>, mega_fwd<32>, mega_fwd<64>, mega_fwd<128>, mega_fwd<256>, mega_fwd<512>, mega_fwd<1024>, mega_fwd<2048> };
    constexpr int NK = 12;
#endif
    if (grid == 0) {
        if (n_in != 27 || in_sizes[0] != NTOK * DM || out_size != NTOK * DM || ws_size < WS_END) { fprintf(stderr, "kernel_launch: unexpected problem shape / workspace (%d inputs, ws %zu)\n", n_in, ws_size); grid = -1; return; }
        int dev = 0, cus = 0, per_cu = 0;
        if (hipGetDevice(&dev) != hipSuccess || hipDeviceGetAttribute(&cus, hipDeviceAttributeMultiprocessorCount, dev) != hipSuccess) { grid = -1; return; }
        for (int k = 0; k < NK; ++k) {
            if (hipFuncSetAttribute((const void*)kerns[k], hipFuncAttributeMaxDynamicSharedMemorySize, LDS_BYTES) != hipSuccess) { grid = -1; return; }
            if (hipOccupancyMaxActiveBlocksPerMultiprocessor(&per_cu, (const void*)kerns[k], 512, LDS_BYTES) != hipSuccess || per_cu < 1) { fprintf(stderr, "kernel_launch: occupancy query reports %d blocks/CU\n", per_cu); grid = -1; (void)hipGetLastError(); return; }
        }
        grid = cus;
    }
    if (grid < 0) return;
    (void)hipMemsetAsync((char*)d_ws + WS_CTL, 0, CTL_ZERO_BYTES, stream);
    Args a{};
    for (int i = 0; i < 27; ++i) a.in[i] = (const float*)d_in[i];
    a.out = (float*)d_out; a.ws = (unsigned char*)d_ws;
#if MK_ONE_LAUNCH
    a.ph_lo = 0; a.ph_hi = N_PHASES; a.li = 0;
    hipLaunchKernelGGL(kerns[0], dim3(grid), dim3(512), LDS_BYTES, stream, a);
#else
    for (int p = 0; p < N_PHASES; ++p) { a.ph_lo = p; a.ph_hi = p + 1; a.li = p; hipLaunchKernelGGL(kerns[p], dim3(grid), dim3(512), LDS_BYTES, stream, a); }
#endif
}
```

```cpp
#include <hip/hip_runtime.h>
#include <cstdio>
#include <cstdint>

#ifndef MK_ONE_LAUNCH
#define MK_ONE_LAUNCH 1
#endif

namespace pg8 {
#define PG8_LAS __attribute__((address_space(3)))
typedef unsigned short bf16_t;
typedef short bf16x8 __attribute__((ext_vector_type(8)));
typedef float f32x4 __attribute__((ext_vector_type(4)));
typedef unsigned u32x4 __attribute__((ext_vector_type(4)));
constexpr int BM = 256, BK = 64, HALF = 128, HTB = HALF * BK * 2  , STAGE_BYTES = 8 * HTB, NXCD = 8, WGM = 8;

__host__ __device__ __forceinline__ int lds_byte(int r, int c) { const int st = (r >> 4) * 2 + (c >> 5), rr = r & 15, cc = c & 31, ob = rr * 64 + cc * 2; return st * 1024 + (ob ^ (((ob >> 9) & 1) << 5)); }
__host__ __device__ __forceinline__ void stage_rc(int b, int& R, int& C) { const int st = b / 1024, sb = b % 1024, swz = sb ^ (((sb >> 9) & 1) << 5); R = (st >> 1) * 16 + swz / 64; C = (st & 1) * 32 + (swz % 64) / 2; }
__host__ __device__ __forceinline__ int perm32(int rho) { const int n = rho >> 4, i = rho & 15; return 8 * (i >> 2) + 4 * n + (i & 3); }

struct Unit { int pm, pn; };
struct Gemm { const bf16_t* A; const bf16_t* Bt; int M, N, K; };

struct StaticOrder {
    int nM, nN, nwg, G, c;
    __host__ __device__ void init(int M, int N, int G_, int c_) { nM = M / BM; nN = N / BM; nwg = nM * nN; G = G_; c = c_; }
    __host__ __device__ bool next(int i, Unit& u) const {
        const long L = (long)i * G + c; if (L >= nwg) return false;
        int wgid = (int)L; { const int q = nwg / NXCD, r = nwg % NXCD, xcd = wgid % NXCD, off = wgid / NXCD; wgid = (xcd < r ? xcd * (q + 1) : r * (q + 1) + (xcd - r) * q) + off; }
        const int nig = WGM * nN, gid = wgid / nig, fm = gid * WGM, gsz = (nM - fm) < WGM ? (nM - fm) : WGM;
        u.pm = fm + ((wgid % nig) % gsz); u.pn = (wgid % nig) / gsz; return true;
    }
    __device__ __forceinline__ void a_ready(const Unit&) const {}
    __device__ __forceinline__ void done(const Unit&) const {}
};

template <class Epi, class Sched, bool ALIGN_EPI = false, bool SP2 = false>
__device__ __forceinline__ void gemm_phase(PG8_LAS unsigned char* lds, const Gemm g, const Sched& S, const Epi& E, int wave_id_) {
    int tid_o_; asm volatile("v_mbcnt_lo_u32_b32 %0, -1, 0\n\tv_mbcnt_hi_u32_b32 %0, -1, %0" : "=v"(tid_o_)); tid_o_ += wave_id_ * 64;
    const int tid = tid_o_, wid = __builtin_amdgcn_readfirstlane(tid >> 6), lane = tid & 63, wr = wid >> 2, wc = wid & 3, fr = lane & 15, fq = lane >> 4;
    const int K = g.K, nt = K / BK;
    unsigned voffA[2], voffB[2];
#pragma unroll
    for (int i = 0; i < 2; ++i) { int R, C; stage_rc(tid * 16 + i * 8192, R, C); const int Rb = Epi::PERM ? ((R & ~31) + perm32(R & 31)) : R;
        voffA[i] = (unsigned)(R * K + C) * 2u; voffB[i] = (unsigned)(Rb * K + C) * 2u; }
    const size_t kstep = (size_t)(BK * 2);
    const size_t hstep = (size_t)HALF * K * 2;
    const size_t tstep = 2 * hstep;
    const unsigned ldsw = (unsigned)wid * 1024u;
    const int aoff = lds_byte(wr * 64 + fr, fq * 8), boff = lds_byte(wc * 32 + fr, fq * 8);
#define PG8_SA(b, h) (((b) * 2 + (h)) * HTB)
#define PG8_SB(b, h) ((4 + (b) * 2 + (h)) * HTB)
#define PG8_STAGE(bufoff, gbase, voff) do { _Pragma("unroll") for (int _i = 0; _i < 2; ++_i) \
        __builtin_amdgcn_global_load_lds((const unsigned*)((const char*)(gbase) + (voff)[_i]), (PG8_LAS unsigned*)(lds + (bufoff) + ldsw + _i * 8192), 16, 0, 0); } while (0)
#define PG8_LDA(dst, b, h) do { _Pragma("unroll") for (int m = 0; m < 4; ++m) _Pragma("unroll") for (int k = 0; k < 2; ++k) dst[m][k] = *(const PG8_LAS bf16x8*)(lds + PG8_SA(b, h) + aoff + m * 2048 + k * 1024); } while (0)
#define PG8_LDB(dst, b, h) do { _Pragma("unroll") for (int n = 0; n < 2; ++n) _Pragma("unroll") for (int k = 0; k < 2; ++k) dst[n][k] = *(const PG8_LAS bf16x8*)(lds + PG8_SB(b, h) + boff + n * 2048 + k * 1024); } while (0)
#define PG8_MMA(ai, bj, At, Bt) do { __builtin_amdgcn_s_setprio(1); _Pragma("unroll") for (int m = 0; m < 4; ++m) _Pragma("unroll") for (int n = 0; n < 2; ++n) _Pragma("unroll") for (int k = 0; k < 2; ++k) \
        acc[ai][bj][m][n] = __builtin_amdgcn_mfma_f32_16x16x32_bf16(Bt[n][k], At[m][k], acc[ai][bj][m][n], 0, 0, 0); __builtin_amdgcn_s_setprio(0); } while (0)
#define PG8_WAIT_V(n) asm volatile("s_waitcnt vmcnt(" #n ")" ::: "memory")
#define PG8_WAIT_L(n) asm volatile("s_waitcnt lgkmcnt(" #n ")" ::: "memory")
#define PG8_BAR __builtin_amdgcn_s_barrier()
#define PG8_SCHED __builtin_amdgcn_sched_barrier(0)
    Unit cur, nxt; int ui = 0;
    if (!S.next(0, cur)) return;
    f32x4 acc[2][2][4][2];
#pragma unroll
    for (int a = 0; a < 2; ++a)
#pragma unroll
        for (int b = 0; b < 2; ++b)
#pragma unroll
            for (int m = 0; m < 4; ++m)
#pragma unroll
                for (int n = 0; n < 2; ++n) acc[a][b][m][n] = (f32x4){0.f, 0.f, 0.f, 0.f};
    bf16x8 At[4][2], B0[2][2], B1[2][2];
    const char* cA = (const char*)g.A + (size_t)cur.pm * tstep; const char* cB = (const char*)g.Bt + (size_t)cur.pn * tstep;
    S.a_ready(cur);
    if constexpr (SP2) {
        PG8_STAGE(PG8_SB(0, 0), cB, voffB); PG8_STAGE(PG8_SB(0, 1), cB + hstep, voffB); PG8_STAGE(PG8_SA(0, 0), cA, voffA); PG8_STAGE(PG8_SA(0, 1), cA + hstep, voffA);
        if (wr == 1) PG8_BAR;
        PG8_WAIT_V(2); PG8_BAR;
        PG8_STAGE(PG8_SB(1, 0), cB + kstep, voffB); PG8_STAGE(PG8_SA(1, 0), cA + kstep, voffA); PG8_STAGE(PG8_SB(1, 1), cB + hstep + kstep, voffB);
        PG8_WAIT_V(6); PG8_BAR;
    } else {
        PG8_STAGE(PG8_SB(0, 0), cB, voffB); PG8_STAGE(PG8_SA(0, 0), cA, voffA); PG8_STAGE(PG8_SB(0, 1), cB + hstep, voffB); PG8_STAGE(PG8_SA(0, 1), cA + hstep, voffA);
        if (wr == 1) PG8_BAR;
        PG8_WAIT_V(4); PG8_BAR;
        PG8_STAGE(PG8_SB(1, 0), cB + kstep, voffB); PG8_STAGE(PG8_SA(1, 0), cA + kstep, voffA); PG8_STAGE(PG8_SB(1, 1), cB + hstep + kstep, voffB);
        PG8_WAIT_V(6); PG8_BAR;
    }
    for (;;) {
        const bool has_next = S.next(ui + 1, nxt);
        const char* nA = has_next ? (const char*)g.A + (size_t)nxt.pm * tstep : cA; const char* nB = has_next ? (const char*)g.Bt + (size_t)nxt.pn * tstep : cB;
        for (int t = 0; t < nt; t += 2) {
            const bool last = (t == nt - 2);
            const char* a1 = cA + (size_t)(t + 1) * kstep;
            const char* a2 = last ? nA : cA + (size_t)(t + 2) * kstep; const char* b2 = last ? nB : cB + (size_t)(t + 2) * kstep;
            const char* a3 = a2 + kstep; const char* b3 = b2 + kstep;
            if (last && has_next) S.a_ready(nxt);
            if constexpr (SP2) {
            PG8_LDB(B0, 0, 0); PG8_LDB(B1, 0, 1); PG8_SCHED; PG8_LDA(At, 0, 0); PG8_STAGE(PG8_SA(1, 1), a1 + hstep, voffA);
            PG8_WAIT_V(8); PG8_WAIT_L(0); PG8_BAR; PG8_MMA(0, 0, At, B0); PG8_MMA(0, 1, At, B1); PG8_BAR; PG8_SCHED;
            PG8_LDA(At, 0, 1); PG8_STAGE(PG8_SB(0, 0), b2, voffB); PG8_STAGE(PG8_SB(0, 1), b2 + hstep, voffB); PG8_STAGE(PG8_SA(0, 0), a2, voffA);
            PG8_WAIT_V(8); PG8_WAIT_L(0); PG8_BAR; PG8_MMA(1, 0, At, B0); PG8_MMA(1, 1, At, B1); PG8_BAR; PG8_SCHED;
            PG8_LDB(B0, 1, 0); PG8_LDB(B1, 1, 1); PG8_SCHED; PG8_LDA(At, 1, 0); PG8_STAGE(PG8_SA(0, 1), a2 + hstep, voffA);
            PG8_WAIT_V(8); PG8_WAIT_L(0); PG8_BAR; PG8_MMA(0, 0, At, B0); PG8_MMA(0, 1, At, B1); PG8_BAR; PG8_SCHED;
            PG8_LDA(At, 1, 1); PG8_STAGE(PG8_SB(1, 0), b3, voffB); PG8_STAGE(PG8_SB(1, 1), b3 + hstep, voffB); PG8_STAGE(PG8_SA(1, 0), a3, voffA);
            PG8_WAIT_V(8); PG8_WAIT_L(0); PG8_BAR; PG8_MMA(1, 0, At, B0); PG8_MMA(1, 1, At, B1); PG8_BAR; PG8_SCHED;
            } else {
            PG8_LDB(B0, 0, 0); PG8_SCHED; PG8_LDA(At, 0, 0); PG8_STAGE(PG8_SA(1, 1), a1 + hstep, voffA);
            PG8_WAIT_L(8); PG8_BAR; PG8_WAIT_L(0); PG8_MMA(0, 0, At, B0); PG8_BAR; PG8_SCHED;
            PG8_LDB(B1, 0, 1); PG8_STAGE(PG8_SB(0, 0), b2, voffB);
            PG8_BAR; PG8_WAIT_L(0); PG8_MMA(0, 1, At, B1); PG8_BAR;
            PG8_LDA(At, 0, 1); PG8_STAGE(PG8_SA(0, 0), a2, voffA);
            PG8_BAR; PG8_WAIT_L(0); PG8_MMA(1, 0, At, B0); PG8_BAR; PG8_SCHED;
            PG8_STAGE(PG8_SB(0, 1), b2 + hstep, voffB);
            PG8_WAIT_V(6); PG8_BAR; PG8_MMA(1, 1, At, B1); PG8_BAR;
            PG8_LDB(B0, 1, 0); PG8_SCHED; PG8_LDA(At, 1, 0); PG8_STAGE(PG8_SA(0, 1), a2 + hstep, voffA);
            PG8_WAIT_L(8); PG8_BAR; PG8_WAIT_L(0); PG8_MMA(0, 0, At, B0); PG8_BAR; PG8_SCHED;
            PG8_LDB(B1, 1, 1); PG8_STAGE(PG8_SB(1, 0), b3, voffB);
            PG8_BAR; PG8_WAIT_L(0); PG8_MMA(0, 1, At, B1); PG8_BAR;
            PG8_LDA(At, 1, 1); PG8_STAGE(PG8_SA(1, 0), a3, voffA);
            PG8_BAR; PG8_WAIT_L(0); PG8_MMA(1, 0, At, B0); PG8_BAR; PG8_SCHED;
            PG8_STAGE(PG8_SB(1, 1), b3 + hstep, voffB);
            PG8_WAIT_V(6); PG8_BAR; PG8_MMA(1, 1, At, B1); PG8_BAR;
            }
        }
        if constexpr (ALIGN_EPI) { if (wr == 0) PG8_BAR; }
        if constexpr (Epi::CHAIN) { if ((ui & 1) == 0) E.mid(acc, cur, wr, wc, fr, fq); else E(acc, cur, wr, wc, fr, fq); }
        else if constexpr (!Epi::AFTER_DRAIN) { E(acc, cur, wr, wc, fr, fq); S.done(cur); }
        if (!has_next) break;
        const bool zero_acc_ = !Epi::CHAIN || (ui & 1) == 1;
#pragma unroll
        for (int a = 0; a < 2; ++a)
#pragma unroll
            for (int b = 0; b < 2; ++b)
#pragma unroll
                for (int m = 0; m < 4; ++m)
#pragma unroll
                    for (int n = 0; n < 2; ++n) if (zero_acc_) acc[a][b][m][n] = (f32x4){0.f, 0.f, 0.f, 0.f};
        cur = nxt; cA = nA; cB = nB; ++ui;
        if constexpr (ALIGN_EPI) { if (wr == 1) PG8_BAR; }
    }
    PG8_WAIT_V(0);
    if constexpr (!ALIGN_EPI) { if (wr == 0) PG8_BAR; }
    PG8_BAR;
    if constexpr (Epi::AFTER_DRAIN) { E.fused(acc, cur, wr, wc, fr, fq, lds, wid, lane); S.done(cur); }
#undef PG8_SA
#undef PG8_SB
#undef PG8_STAGE
#undef PG8_LDA
#undef PG8_LDB
#undef PG8_MMA
#undef PG8_WAIT_V
#undef PG8_WAIT_L
#undef PG8_BAR
#undef PG8_SCHED
}
}

constexpr int NTOK = 8192, SEQ = 2048, DM = 2048, NB = 4;
constexpr int ZR_LD = 3520, ZN_LD = 2608, ZG_LD = 4096, INC = 10224, INCP = 10240;
constexpr int DFF = 8192;
constexpr int ZN_Q = 0, ZN_KC = 1024, ZN_VC = 1280, ZN_KS = 1536, ZN_VS = 1792, ZN_KW = 2048, ZN_VW = 2304, ZN_GATE = 2560;

typedef unsigned short bf16;
typedef short bf16x8 __attribute__((ext_vector_type(8)));
typedef float f32x4 __attribute__((ext_vector_type(4)));
typedef float f32x16 __attribute__((ext_vector_type(16)));
typedef unsigned u32x4 __attribute__((ext_vector_type(4)));
typedef unsigned u32x2 __attribute__((ext_vector_type(2)));
typedef short s16x4 __attribute__((ext_vector_type(4)));
#define GAS __attribute__((address_space(1)))
#define LAS __attribute__((address_space(3)))
typedef GAS unsigned gu32;

__device__ __forceinline__ float bf2f(unsigned u) { return __uint_as_float(u << 16); }
__device__ __forceinline__ unsigned f2bf(float f) { unsigned u = __float_as_uint(f); return (u + 0x7fffu + ((u >> 16) & 1u)) >> 16; }
__device__ __forceinline__ unsigned pk2(float lo, float hi) { return f2bf(lo) | (f2bf(hi) << 16); }
__device__ __forceinline__ u32x4 pack8(const f32x4 a, const f32x4 b) { u32x4 w; w.x = pk2(a[0], a[1]); w.y = pk2(a[2], a[3]); w.z = pk2(b[0], b[1]); w.w = pk2(b[2], b[3]); return w; }
__device__ __forceinline__ float sigmoidf_(float x) { return __builtin_amdgcn_rcpf(1.0f + __expf(-x)); }
__device__ __forceinline__ float wave_sum(float v) {
#pragma unroll
    for (int o = 1; o < 64; o <<= 1) v += __shfl_xor(v, o);
    return v;
}

constexpr size_t MiB = 1u << 20;
constexpr size_t WS_CTL = 0, CTL_ZERO_BYTES = 1 * MiB;
constexpr size_t CTL_ROWSQ1 = 256 * 1024, CTL_ROWSQ2 = 320 * 1024;
constexpr size_t WS_LORAT = 1 * MiB, WS_W1T = 3 * MiB, WS_WOUTT = 5 * MiB, WS_WOT = 13 * MiB, WS_MISC = 21 * MiB;
constexpr size_t WS_WINT = 22 * MiB, WS_XN = 62 * MiB;
constexpr size_t WS_LORA = 22 * MiB;
constexpr size_t WS_SALL = 22 * MiB;
constexpr size_t WS_MIXED = 22 * MiB;
constexpr size_t WS_H1B = 54 * MiB;
constexpr size_t WS_QC = 70 * MiB, WS_YH = 86 * MiB;
constexpr size_t WS_ZR = 102 * MiB, WS_ZN = 158 * MiB, WS_ZG = 202 * MiB;
constexpr size_t WS_UPT = 102 * MiB, WS_DOWNT = 134 * MiB;
constexpr size_t WS_ACT = 166 * MiB;
constexpr size_t WS_A2 = 266 * MiB, WS_AG = 278 * MiB, WS_HPART = 294 * MiB;
constexpr size_t WS_BON = 266 * MiB;
constexpr size_t WS_YAB = 282 * MiB;
constexpr size_t WS_KCV = 314 * MiB;
constexpr size_t WS_END = 315 * MiB;
constexpr int CW_TMO = 0, CW_BAR = 4096;

constexpr int RING_BYTES = 131072, LDSCTL_OFF = RING_BYTES, MISC_OFF = LDSCTL_OFF + 320, LDS_BYTES = 147456;

__device__ __forceinline__ void tile_decode(int wgid, int nwg, int nM, int nN, int& pm, int& pn) {
    const int q = nwg / 8, r = nwg % 8, xcd = wgid % 8, off = wgid / 8;
    wgid = (xcd < r ? xcd * (q + 1) : r * (q + 1) + (xcd - r) * q) + off;
    const int nig = 8 * nN, gid = wgid / nig, fm = gid * 8, gsz = (nM - fm) < 8 ? (nM - fm) : 8;
    pm = fm + ((wgid % nig) % gsz); pn = (wgid % nig) / gsz;
}
template <int nM, int nN, int nblk>
struct CatOrder {
    int G, c;
    __device__ void init(int G_, int c_) { G = G_; c = c_; }
    __device__ bool next(int i, pg8::Unit& u) const {
        constexpr int nbase = nM * nN;
        const int L = i * G + c; if (L >= nbase * nblk) return false;
        const int blk = L / nbase, w = L % nbase; int pm, pn; tile_decode(w, nbase, nM, nN, pm, pn);
        u.pm = pm + blk * nM; u.pn = pn + blk * nN; return true;
    }
    __device__ __forceinline__ void a_ready(const pg8::Unit&) const {}
    __device__ __forceinline__ void done(const pg8::Unit&) const {}
};
template <int nM, int nN>
struct PairOrder {
    int G, c;
    __device__ void init(int G_, int c_) { G = G_; c = c_; }
    __device__ bool next(int i, pg8::Unit& u) const {
        constexpr int nbase = nM * nN;
        const int L = (i >> 1) * G + c; if (L >= nbase) return false;
        int pm, pn; tile_decode(L, nbase, nM, nN, pm, pn);
        u.pm = pm + (i & 1) * nM; u.pn = pn + (i & 1) * nN; return true;
    }
    __device__ __forceinline__ void a_ready(const pg8::Unit&) const {}
    __device__ __forceinline__ void done(const pg8::Unit&) const {}
};

typedef const f32x4 (&AccC)[2][2][4][2];
typedef f32x4 (&AccM)[2][2][4][2];

struct EpiProj {
    static constexpr bool PERM = true, AFTER_DRAIN = false, CHAIN = false;
    bf16 *ZR, *ZN, *ZG;
    __device__ __forceinline__ void operator()(AccC acc, const pg8::Unit& u, int wr, int wc, int fr, int fq) const {
        const int row0 = u.pm * 256 + wr * 64 + fr;
#pragma unroll
        for (int bj = 0; bj < 2; ++bj) {
            const int c = u.pn * 256 + bj * 128 + wc * 32 + 8 * fq;
            bf16* p; int ld;
            if (c < 3520) { p = ZR + c; ld = ZR_LD; } else if (c < 6128) { p = ZN + (c - 3520); ld = ZN_LD; } else if (c < INC) { p = ZG + (c - 6128); ld = ZG_LD; } else continue;
#pragma unroll
            for (int ai = 0; ai < 2; ++ai)
#pragma unroll
                for (int m = 0; m < 4; ++m) { const int row = row0 + ai * 128 + m * 16; *(u32x4*)(p + (size_t)row * ld) = pack8(acc[ai][bj][m][0], acc[ai][bj][m][1]); }
        }
    }
};
struct EpiLora {
    static constexpr bool PERM = true, AFTER_DRAIN = false, CHAIN = false;
    bf16* LORA; const float* w0; const float* a0;
    template <int WHICH> __device__ __forceinline__ void run(AccC acc, const pg8::Unit& u, int wr, int wc, int fr, int fq) const {
        const int row0 = (u.pm - 32 * WHICH) * 256 + wr * 64 + fr;
        const float* bp = WHICH == 0 ? w0 : a0;
#pragma unroll
        for (int bj = 0; bj < 2; ++bj) {
            const int col = (u.pn & 3) * 256 + bj * 128 + wc * 32 + 8 * fq;
            f32x4 bias0 = (f32x4){0.f, 0.f, 0.f, 0.f}, bias1 = bias0;
            if (WHICH < 2) { bias0 = *(const f32x4*)(bp + col); bias1 = *(const f32x4*)(bp + col + 4); }
            bf16* p = LORA + ((size_t)WHICH * NTOK + row0) * 1024 + col;
#pragma unroll
            for (int ai = 0; ai < 2; ++ai)
#pragma unroll
                for (int m = 0; m < 4; ++m) {
                    f32x4 v0 = acc[ai][bj][m][0] + bias0, v1 = acc[ai][bj][m][1] + bias1;
                    if (WHICH < 2) {
#pragma unroll
                        for (int e = 0; e < 4; ++e) { v0[e] = sigmoidf_(v0[e]); v1[e] = sigmoidf_(v1[e]); }
                        if (WHICH == 0) { v0 = v0 * -0.6065306597f; v1 = v1 * -0.6065306597f; }
                    }
                    *(u32x4*)(p + (size_t)(ai * 128 + m * 16) * 1024) = pack8(v0, v1);
                }
        }
    }
    __device__ __forceinline__ void operator()(AccC acc, const pg8::Unit& u, int wr, int wc, int fr, int fq) const {
        const int which = u.pn >> 2;
#ifdef LORA_PROBE
        run<2>(acc, u, wr, wc, fr, fq);
#else
        if (which == 0) run<0>(acc, u, wr, wc, fr, fq); else if (which == 1) run<1>(acc, u, wr, wc, fr, fq); else run<2>(acc, u, wr, wc, fr, fq);
#endif
    }
};
struct EpiHpart {
    static constexpr bool PERM = false, AFTER_DRAIN = false, CHAIN = false;
    float* C;
    __device__ __forceinline__ void operator()(AccC acc, const pg8::Unit& u, int wr, int wc, int fr, int fq) const {
        const int row0 = u.pm * 256 + wr * 64 + fr, col0 = wc * 32 + 4 * fq;
#pragma unroll
        for (int ai = 0; ai < 2; ++ai)
#pragma unroll
            for (int m = 0; m < 4; ++m) { float* rowp = C + (size_t)(row0 + ai * 128 + m * 16) * 256 + col0;
#pragma unroll
                for (int bj = 0; bj < 2; ++bj)
#pragma unroll
                    for (int n = 0; n < 2; ++n) *(f32x4*)(rowp + bj * 128 + n * 16) = acc[ai][bj][m][n]; }
    }
};
struct EpiMerge {
    static constexpr bool PERM = true, AFTER_DRAIN = false, CHAIN = false;
    const bf16* ZG; bf16* MIXED;
    __device__ __forceinline__ void operator()(AccC acc, const pg8::Unit& u, int wr, int wc, int fr, int fq) const {
        const int second = u.pm >= 32 ? 1 : 0;
        const int row0 = (u.pm - 32 * second) * 256 + wr * 64 + fr, colb = (u.pn - 8 * second) * 256 + wc * 32 + 8 * fq;
#pragma unroll
        for (int ai = 0; ai < 2; ++ai)
#pragma unroll
            for (int m = 0; m < 4; ++m) {
                const size_t row = (size_t)(row0 + ai * 128 + m * 16);
#pragma unroll
                for (int bj = 0; bj < 2; ++bj) {
                    const u32x4 gt = *(const u32x4*)(ZG + row * ZG_LD + 2048 * second + colb + bj * 128);
                    u32x4 prev = (u32x4){0u, 0u, 0u, 0u};
                    if (second) prev = *(const u32x4*)(MIXED + row * DM + colb + bj * 128);
                    float v[8];
#pragma unroll
                    for (int e = 0; e < 8; ++e) {
                        const float gv = (e & 1) ? bf2f(gt[e >> 1] >> 16) : bf2f(gt[e >> 1] & 0xffffu), pv = (e & 1) ? bf2f(prev[e >> 1] >> 16) : bf2f(prev[e >> 1] & 0xffffu);
                        v[e] = pv + acc[ai][bj][m][e >> 2][e & 3] * sigmoidf_(gv);
                    }
                    u32x4 w; w.x = pk2(v[0], v[1]); w.y = pk2(v[2], v[3]); w.z = pk2(v[4], v[5]); w.w = pk2(v[6], v[7]);
                    *(u32x4*)(MIXED + row * DM + colb + bj * 128) = w;
                }
                asm volatile("" ::: "memory");
            }
    }
};
struct EpiWo {
    static constexpr bool PERM = false, AFTER_DRAIN = false, CHAIN = false;
    const float* X; float* H1; bf16* H1B; float* rowsq;
    __device__ __forceinline__ void operator()(AccC acc, const pg8::Unit& u, int wr, int wc, int fr, int fq) const {
        const int row0 = u.pm * 256 + wr * 64 + fr, col0 = u.pn * 256 + wc * 32 + 4 * fq;
#pragma unroll
        for (int ai = 0; ai < 2; ++ai)
#pragma unroll
            for (int m = 0; m < 4; ++m) {
                const int row = row0 + ai * 128 + m * 16; const size_t off = (size_t)row * DM + col0; float ss = 0.f;
#pragma unroll
                for (int bj = 0; bj < 2; ++bj)
#pragma unroll
                    for (int n = 0; n < 2; ++n) {
                        const f32x4 h = *(const f32x4*)(X + off + bj * 128 + n * 16) + acc[ai][bj][m][n];
                        *(f32x4*)(H1 + off + bj * 128 + n * 16) = h;
                        u32x2 w; w.x = pk2(h[0], h[1]); w.y = pk2(h[2], h[3]); *(u32x2*)(H1B + off + bj * 128 + n * 16) = w;
                        ss += (h[0] * h[0] + h[1] * h[1]) + (h[2] * h[2] + h[3] * h[3]);
                    }
                ss += __shfl_xor(ss, 16); ss += __shfl_xor(ss, 32);
                if (fq == 0) atomicAdd(rowsq + row, ss);
            }
    }
};
struct EpiUp {
    static constexpr bool PERM = true, AFTER_DRAIN = false, CHAIN = false;
    const float* rowsq; bf16* ACT;
    __device__ __forceinline__ void operator()(AccC acc, const pg8::Unit& u, int wr, int wc, int fr, int fq) const {
        const int row0 = u.pm * 256 + wr * 64 + fr;
#pragma unroll
        for (int ai = 0; ai < 2; ++ai)
#pragma unroll
            for (int m = 0; m < 4; ++m) {
                const int row = row0 + ai * 128 + m * 16;
                const float rs = rsqrtf(__hip_atomic_load(rowsq + row, __ATOMIC_RELAXED, __HIP_MEMORY_SCOPE_AGENT) * (1.0f / DM) + 1e-5f);
#pragma unroll
                for (int bj = 0; bj < 2; ++bj) {
                    const int col = u.pn * 256 + bj * 128 + wc * 32 + 8 * fq; float v[8];
#pragma unroll
                    for (int e = 0; e < 8; ++e) { const float x = fmaxf(acc[ai][bj][m][e >> 2][e & 3] * rs, 0.f); v[e] = x * x; }
                    u32x4 w; w.x = pk2(v[0], v[1]); w.y = pk2(v[2], v[3]); w.z = pk2(v[4], v[5]); w.w = pk2(v[6], v[7]);
                    *(u32x4*)(ACT + (size_t)row * DFF + col) = w;
                }
            }
    }
};
struct EpiDown {
    static constexpr bool PERM = false, AFTER_DRAIN = false, CHAIN = false;
    float* H; float* rowsq;
    __device__ __forceinline__ void operator()(AccC acc, const pg8::Unit& u, int wr, int wc, int fr, int fq) const {
        const int row0 = u.pm * 256 + wr * 64 + fr, col0 = u.pn * 256 + wc * 32 + 4 * fq;
#pragma unroll
        for (int ai = 0; ai < 2; ++ai)
#pragma unroll
            for (int m = 0; m < 4; ++m) {
                const int row = row0 + ai * 128 + m * 16; const size_t off = (size_t)row * DM + col0; float ss = 0.f;
#pragma unroll
                for (int bj = 0; bj < 2; ++bj)
#pragma unroll
                    for (int n = 0; n < 2; ++n) {
                        const f32x4 h = *(const f32x4*)(H + off + bj * 128 + n * 16) + acc[ai][bj][m][n];
                        *(f32x4*)(H + off + bj * 128 + n * 16) = h;
                        ss += (h[0] * h[0] + h[1] * h[1]) + (h[2] * h[2] + h[3] * h[3]);
                    }
                ss += __shfl_xor(ss, 16); ss += __shfl_xor(ss, 32);
                if (fq == 0) atomicAdd(rowsq + row, ss);
            }
    }
};
#define XB_TMO      128
#define XB_XCNT(j)  (256  + 64 * (j))
#define XB_XSUB(j)  (1280 + 64 * (j))
#define XB_XGEN(j)  (2304 + 64 * (j))
#define XB_TOP      3328
#define XB_TOPGEN   3392
#define XCD_BAR_WORDS 3456
#define XB_SPIN_CAP (1u << 18)

__device__ __forceinline__ unsigned xb_ld(unsigned* p)              { return __hip_atomic_load(p, __ATOMIC_RELAXED, __HIP_MEMORY_SCOPE_AGENT); }
__device__ __forceinline__ unsigned xb_add(unsigned* p, unsigned v) { return __hip_atomic_fetch_add(p, v, __ATOMIC_RELAXED, __HIP_MEMORY_SCOPE_AGENT); }
__device__ __forceinline__ unsigned xb_xcc_id() { return (unsigned)__builtin_amdgcn_s_getreg((3 << 11) | 20) & 0xFu; }
#define XB_SPIN(cond, bar) do { unsigned _sp = 0; while (cond) { __builtin_amdgcn_s_sleep(1); \
    if ((++_sp & 255u) == 0u) { if (xb_ld(&(bar)[XB_TMO])) break; if (_sp > XB_SPIN_CAP) { atomicAdd(&(bar)[XB_TMO], 1u); break; } } } } while (0)

struct XcdBarrier {
    unsigned* bar; unsigned x;
    volatile LAS unsigned* st;
};

__device__ __forceinline__ XcdBarrier xcd_barrier_post(unsigned* bar, volatile LAS unsigned* st, int tid_) {
    XcdBarrier b; b.bar = bar; b.x = xb_xcc_id(); b.st = st;
    if (tid_ == 0) (void)xb_add(&bar[XB_XCNT(b.x)], 1u);
    return b;
}
__device__ __forceinline__ void xcd_barrier_complete(unsigned* bar, unsigned x, unsigned& nloc, unsigned& nx) {
    const unsigned G = gridDim.x * gridDim.y * gridDim.z;
    unsigned sum, cnt, mine, sp = 0u;
    for (;;) {
        sum = 0u; cnt = 0u; mine = 0u;
#pragma unroll
        for (unsigned j = 0; j < 16; ++j) { const unsigned c = xb_ld(&bar[XB_XCNT(j)]); sum += c; cnt += (c > 0u) ? 1u : 0u; mine = (j == x) ? c : mine; }
        if (sum == G) break;
        __builtin_amdgcn_s_sleep(1);
        if ((++sp & 255u) == 0u) { if (xb_ld(&bar[XB_TMO])) break; if (sp > XB_SPIN_CAP) { atomicAdd(&bar[XB_TMO], 1u); break; } }
    }
    nloc = mine > 0u ? mine : 1u; nx = cnt > 0u ? cnt : 1u;
}

__device__ __forceinline__ void xcd_barrier(const XcdBarrier& b, int tid_) {
    asm volatile("s_waitcnt vmcnt(0)" ::: "memory");
    __syncthreads();
    if (tid_ == 0) {
        unsigned* bar = b.bar;
        __builtin_amdgcn_s_waitcnt(0);
        unsigned nloc = b.st[0], nx = b.st[1];
        if (nloc == 0u) { xcd_barrier_complete(bar, b.x, nloc, nx); b.st[0] = nloc; b.st[1] = nx; }
        const unsigned old = xb_add(&bar[XB_XSUB(b.x)], 1u);
        const unsigned gen = old / nloc;
        if (old + 1u == (gen + 1u) * nloc) {
            __builtin_amdgcn_fence(__ATOMIC_RELEASE, "agent");
            asm volatile("s_waitcnt vmcnt(0)" ::: "memory");
            const unsigned og = xb_add(&bar[XB_TOP], 1u);
            const unsigned tg = og / nx;
            if (og + 1u == (tg + 1u) * nx) xb_add(&bar[XB_TOPGEN], 1u);
            else XB_SPIN(xb_ld(&bar[XB_TOPGEN]) == tg, bar);
            __builtin_amdgcn_fence(__ATOMIC_ACQUIRE, "agent");
            xb_add(&bar[XB_XGEN(b.x)], 1u);
            asm volatile("s_waitcnt vmcnt(0)" ::: "memory");
        } else {
            XB_SPIN(xb_ld(&bar[XB_XGEN(b.x)]) == gen, bar);
            __builtin_amdgcn_fence(__ATOMIC_ACQUIRE, "agent");
            asm volatile("s_waitcnt vmcnt(0)" ::: "memory");
        }
    }
    __syncthreads();
}

struct Args { const float* in[27]; float* out; unsigned char* ws; int ph_lo, ph_hi, li, pad; };
struct Frame {
    LAS unsigned char* lds;
    int tid, lane, wave, vcu, G;
    const float* const* in;
};
#define LDS_WAIT() asm volatile("s_waitcnt lgkmcnt(0)" ::: "memory")

__device__ __forceinline__ void cvt_item(const float* W, int ldw, int Kv, int Nv, int k0, int n0, bf16* dst, int ldd, const float* ksc, LAS unsigned* scr, int lane) {
    const int q = lane >> 4, nq = lane & 15, n = n0 + 4 * nq;
    f32x4 v[16];
#pragma unroll
    for (int i = 0; i < 16; ++i) {
        const int k = k0 + (i & 1) + 2 * q + 8 * (i >> 1);
        v[i] = (f32x4){0.f, 0.f, 0.f, 0.f};
        if (k < Kv && n < Nv) { v[i] = *(const f32x4*)(W + (size_t)k * ldw + n); if (ksc) v[i] = v[i] * ksc[k]; }
    }
#pragma unroll
    for (int ip = 0; ip < 8; ++ip)
#pragma unroll
        for (int e = 0; e < 4; ++e) { const int nn = 4 * nq + e; scr[nn * 32 + 4 * (ip ^ (nq & 7)) + q] = pk2(v[2 * ip][e], v[2 * ip + 1][e]); }
    LDS_WAIT(); asm volatile("" ::: "memory");
    const int c = lane & 7;
#pragma unroll
    for (int j = 0; j < 8; ++j) {
        const int nn = (lane >> 3) + 8 * j;
        const u32x4 o = *(const LAS u32x4*)(scr + nn * 32 + 4 * (c ^ ((nn >> 2) & 7)));
        *(u32x4*)(dst + (size_t)(n0 + nn) * ldd + k0 + 8 * c) = o;
    }
    LDS_WAIT(); asm volatile("" ::: "memory");
}
#define CVT_MAT(W_, ldw_, Kv_, Nv_, nkb_, nnb_, dst_, ldd_, ksc_) { const int cnt_ = (nkb_) * (nnb_); if (r < cnt_) { cvt_item(W_, ldw_, Kv_, Nv_, 64 * (r / (nnb_)), 64 * (r % (nnb_)), dst_, ldd_, ksc_, scr, F.lane); continue; } r -= cnt_; }

__device__ __forceinline__ void ph0_prologue(const Frame& F, const Args& A) {
    unsigned char* ws = A.ws;
    LAS unsigned* scr = (LAS unsigned*)(F.lds + F.wave * 8192);
    const int gw = F.vcu * 8 + F.wave, NGW = F.G * 8;
    bf16* WinT = (bf16*)(ws + WS_WINT); bf16* LoraT = (bf16*)(ws + WS_LORAT); bf16* W1T = (bf16*)(ws + WS_W1T); bf16* WoutT = (bf16*)(ws + WS_WOUTT); bf16* WoT = (bf16*)(ws + WS_WOT);
    constexpr int N_WIN = 32 * 160, N_LORA = 4 * 16, N_W1 = 8 * 4, N_WOUT = 16 * 32, N_WO = 32 * 32;
    constexpr int NITEMS = N_WIN + 3 * N_LORA + 8 * N_W1 + 2 * N_WOUT + N_WO;
    for (int it = gw; it < NITEMS; it += NGW) {
        int r = it;
        CVT_MAT(A.in[2], INC, 2048, INC, 32, 160, WinT, 2048, nullptr)
        CVT_MAT(A.in[5], 1024, 96, 1024, 4, 16, LoraT, 256, nullptr)
        CVT_MAT(A.in[7], 1024, 96, 1024, 4, 16, LoraT + 1024 * 256, 256, nullptr)
        CVT_MAT(A.in[8], 1024, 256, 1024, 4, 16, LoraT + 2 * 1024 * 256, 256, nullptr)
#pragma unroll
        for (int ks = 0; ks < 4; ++ks) {
            CVT_MAT(A.in[15] + (size_t)ks * 512 * 256, 256, 512, 256, 8, 4, W1T + (size_t)((ks * 2 + 0) * 256) * 512, 512, nullptr)
            CVT_MAT(A.in[18] + (size_t)ks * 512 * 256, 256, 512, 256, 8, 4, W1T + (size_t)((ks * 2 + 1) * 256) * 512, 512, nullptr)
        }
        CVT_MAT(A.in[20], 2048, 1024, 2048, 16, 32, WoutT, 1024, nullptr)
        CVT_MAT(A.in[21], 2048, 1024, 2048, 16, 32, WoutT + (size_t)2048 * 1024, 1024, nullptr)
        CVT_MAT(A.in[22], 2048, 2048, 2048, 32, 32, WoT, 2048, nullptr)
    }
    {
        const float* x = A.in[0]; const float* nm = A.in[1]; bf16* XN = (bf16*)(ws + WS_XN);
        for (int m = gw; m < NTOK; m += NGW) {
            const f32x4* xr = (const f32x4*)(x + (size_t)m * DM) + F.lane; f32x4 v[8]; float s = 0.f;
#pragma unroll
            for (int j = 0; j < 8; ++j) { v[j] = xr[64 * j]; s += (v[j][0] * v[j][0] + v[j][1] * v[j][1]) + (v[j][2] * v[j][2] + v[j][3] * v[j][3]); }
            const float rstd = rsqrtf(wave_sum(s) * (1.f / DM) + 1e-5f);
#pragma unroll
            for (int j = 0; j < 8; ++j) {
                const f32x4 g = *((const f32x4*)nm + F.lane + 64 * j); u32x2 w;
                w.x = pk2(v[j][0] * rstd * g[0], v[j][1] * rstd * g[1]); w.y = pk2(v[j][2] * rstd * g[2], v[j][3] * rstd * g[3]);
                *((u32x2*)(XN + (size_t)m * DM) + F.lane + 64 * j) = w;
            }
        }
    }
    if (gw < 8) {
        const int which = gw >> 2, c = (gw & 3) * 64 + F.lane;
        const float* pe = which ? A.in[17] : A.in[14]; const float* w1 = which ? A.in[18] : A.in[15];
        float s0 = 0.f, s1 = 0.f, s2 = 0.f, s3 = 0.f;
        for (int k = 0; k < 2048; k += 4) { s0 += pe[k] * w1[(size_t)k * 256 + c]; s1 += pe[k + 1] * w1[(size_t)(k + 1) * 256 + c]; s2 += pe[k + 2] * w1[(size_t)(k + 2) * 256 + c]; s3 += pe[k + 3] * w1[(size_t)(k + 3) * 256 + c]; }
        ((float*)(ws + WS_MISC))[which * 256 + c] = (s0 + s1) + (s2 + s3);
    }
}
__device__ __forceinline__ void ph_cvt_mlp(const Frame& F, const Args& A) {
    unsigned char* ws = A.ws;
    LAS unsigned* scr = (LAS unsigned*)(F.lds + F.wave * 8192);
    const int gw = F.vcu * 8 + F.wave, NGW = F.G * 8;
    bf16* UpT = (bf16*)(ws + WS_UPT); bf16* DownT = (bf16*)(ws + WS_DOWNT);
    constexpr int NITEMS = 32 * 128 + 128 * 32;
    for (int it = gw; it < NITEMS; it += NGW) {
        int r = it;
        CVT_MAT(A.in[24], DFF, 2048, DFF, 32, 128, UpT, 2048, A.in[23])
        CVT_MAT(A.in[25], 2048, DFF, 2048, 128, 32, DownT, DFF, nullptr)
    }
}

__device__ __forceinline__ void ph2_build(const Frame& F, const Args& A) {
    unsigned char* ws = A.ws;
    const bf16* ZR = (const bf16*)(ws + WS_ZR); const bf16* ZN = (const bf16*)(ws + WS_ZN);
    bf16* A2 = (bf16*)(ws + WS_A2); bf16* Ag = (bf16*)(ws + WS_AG);
    const float* mu = A.in[3];
    const int gt = F.vcu * 512 + F.tid, NGT = F.G * 512;
    for (int idx = gt; idx < 3 * NTOK * 32; idx += NGT) {
        const int blk = idx / (NTOK * 32), row = (idx >> 5) & (NTOK - 1), c0 = (idx & 31) * 8;
        u32x4 o = (u32x4){0u, 0u, 0u, 0u};
        if (blk == 2 || c0 < 96) {
            const int col = (blk == 0 ? 3072 : (blk == 1 ? 3168 : 3264)) + c0;
            const u32x4 z = *(const u32x4*)(ZR + (size_t)row * ZR_LD + col);
            u32x4 zp = (u32x4){0u, 0u, 0u, 0u};
            if ((row & (SEQ - 1)) != 0) zp = *(const u32x4*)(ZR + (size_t)(row - 1) * ZR_LD + col);
            float v[8];
#pragma unroll
            for (int e = 0; e < 8; ++e) {
                const float a = (e & 1) ? bf2f(z[e >> 1] >> 16) : bf2f(z[e >> 1] & 0xffffu), p = (e & 1) ? bf2f(zp[e >> 1] >> 16) : bf2f(zp[e >> 1] & 0xffffu);
                const float s = a + (p - a) * mu[col + e];
                v[e] = blk == 0 ? tanhf(s) : (blk == 1 ? s : sigmoidf_(s));
            }
            o.x = pk2(v[0], v[1]); o.y = pk2(v[2], v[3]); o.z = pk2(v[4], v[5]); o.w = pk2(v[6], v[7]);
        }
        *(u32x4*)(A2 + (size_t)idx * 8) = o;
    }
    for (int idx = gt; idx < 8 * 2048 * 64; idx += NGT) {
        const int blk = idx >> 17, r = (idx >> 6) & 2047, cg = idx & 63, ks = blk >> 1, which = blk & 1;
        u32x4 o = (u32x4){0u, 0u, 0u, 0u};
        if (r < 2032) {
            const int kf = ks * 512 + cg * 8, l = kf >> 6, dd = kf & 63, b = r / 508, rem = r - b * 508, n = rem >> 2, g = rem & 3;
            o = *(const u32x4*)(ZN + (size_t)(b * SEQ + 16 * n + l) * ZN_LD + (which ? ZN_VC : ZN_KC) + g * 64 + dd);
        }
        *(u32x4*)(Ag + (size_t)idx * 8) = o;
    }
}

__device__ __forceinline__ void cmp_finish_unit(const Frame& F, const Args& A, int u) {
    unsigned char* ws = A.ws;
    const float* Hp = (const float*)(ws + WS_HPART); const float* bias1 = (const float*)(ws + WS_MISC);
    bf16* KCV = (bf16*)(ws + WS_KCV);
    const int which = u >> 6, rb = u & 63;
    const float* w2 = which ? A.in[19] : A.in[16];
    LAS float* h = (LAS float*)F.lds;
    __syncthreads();
    for (int idx = F.tid; idx < 32 * 256; idx += 512) {
        const int r = idx >> 8, c = idx & 255; float v = bias1[which * 256 + c];
#pragma unroll
        for (int ks = 0; ks < 4; ++ks) v += Hp[((size_t)((ks * 2 + which) * 2048) + 32 * rb + r) * 256 + c];
        const float t = 0.7978845608028654f * (v + 0.044715f * v * v * v);
        h[r * 257 + c] = 0.5f * v * (1.f + tanhf(t));
    }
    __syncthreads();
    const int r = F.tid >> 4, dq = F.tid & 15;
    f32x4 acc = (f32x4){0.f, 0.f, 0.f, 0.f};
    for (int c = 0; c < 256; ++c) { const float hv = h[r * 257 + c]; const f32x4 w = *(const f32x4*)(w2 + c * 64 + 4 * dq); acc += hv * w; }
    const int R = 32 * rb + r;
    if (R < 2032) {
        const int b = R / 508, rem = R - b * 508, n = rem >> 2, g = rem & 3;
        u32x2 w; w.x = pk2(acc[0], acc[1]); w.y = pk2(acc[2], acc[3]);
        *(u32x2*)(KCV + (size_t)which * (16 * 128 * 64) + ((size_t)(b * 4 + g) * 128 + n) * 64 + 4 * dq) = w;
    }
    if (u == 0 && F.tid < 512) {
        for (int i = F.tid; i < 2 * 16 * 32; i += 512) { const int wh = i / 512, bg = (i >> 5) & 15, c2 = i & 31; *(unsigned*)(KCV + (size_t)wh * (16 * 128 * 64) + ((size_t)bg * 128 + 127) * 64 + 2 * c2) = 0u; }
    }
}

__device__ __forceinline__ void scan_chunk(const Frame& F, const Args& A, int ch, LAS float* wl) {
    unsigned char* ws = A.ws;
    const bf16* ZR = (const bf16*)(ws + WS_ZR); const bf16* LD = (const bf16*)(ws + WS_LORA); const bf16* AA = LD + (size_t)NTOK * 1024;
    bf16* BON = (bf16*)(ws + WS_BON); bf16* QC = (bf16*)(ws + WS_QC); bf16* YH = (bf16*)(ws + WS_YH);
    float* AC = A.out; float* GC = A.out + (size_t)2048 * 4096;
    const int lane = F.lane, bh = ch >> 5, c = ch & 31, b = bh >> 4, h = bh & 15, hj = h * 64 + lane;
    const float* mu = A.in[3];
    const float mu_r = mu[hj], mu_k = mu[1024 + hj], mu_v = mu[2048 + hj];
    const float kkw = A.in[9][hj], kaw = A.in[10][hj], rkw = A.in[11][hj];
    float SA[64], SG[64];
    int lane_o = lane; asm volatile("" : "+v"(lane_o));
#pragma unroll
    for (int j = 0; j < 64; ++j) { SA[j] = (j == lane_o) ? 1.f : 0.f; SG[j] = 0.f; }
    const size_t row0 = (size_t)b * SEQ + c * 64;
    float pr = 0.f, pk = 0.f, pv = 0.f;
    if (c != 0) { const bf16* zp = ZR + (row0 - 1) * ZR_LD + hj; pr = bf2f(zp[0]); pk = bf2f(zp[1024]); pv = bf2f(zp[2048]); }
    for (int sg = 0; sg < 8; ++sg) {
#pragma unroll 2
        for (int s = 0; s < 8; ++s) {
            const size_t row = row0 + sg * 8 + s;
            const bf16* zp = ZR + row * ZR_LD + hj;
            const float zr = bf2f(zp[0]), zk = bf2f(zp[1024]), zv = bf2f(zp[2048]);
            const float r = zr + (pr - zr) * mu_r, k = zk + (pk - zk) * mu_k, v = zv + (pv - zv) * mu_v;
            pr = zr; pk = zk; pv = zv;
            const float w = __expf(bf2f(LD[row * 1024 + hj])), a = bf2f(AA[row * 1024 + hj]);
            const float kkr = k * kkw; const float n2 = wave_sum(kkr * kkr); const float kk = kkr * rsqrtf(fmaxf(n2, 1e-24f));
            const float kp = k * (1.f + (a - 1.f) * kaw), bb = kk * a; const float rkr = wave_sum(r * kp * rkw);
            LAS float* o = wl + s * 384 + lane;
            o[0] = -kk; o[64] = w; o[128] = bb; o[192] = kp; o[256] = r; o[320] = v;
            BON[row * 1024 + hj] = (bf16)f2bf(rkr * v);
        }
        for (int s = 0; s < 8; ++s) {
            const LAS f32x4* p = (const LAS f32x4*)(wl + s * 384);
            const float vi = wl[s * 384 + 320 + lane];
            float a0 = 0.f, a1 = 0.f, a2 = 0.f, a3 = 0.f, g0 = 0.f, g1 = 0.f, g2 = 0.f, g3 = 0.f;
#pragma unroll
            for (int j4 = 0; j4 < 16; ++j4) {
                const f32x4 nk = p[j4];
                a0 += SA[4 * j4] * nk[0]; a1 += SA[4 * j4 + 1] * nk[1]; a2 += SA[4 * j4 + 2] * nk[2]; a3 += SA[4 * j4 + 3] * nk[3];
                g0 += SG[4 * j4] * nk[0]; g1 += SG[4 * j4 + 1] * nk[1]; g2 += SG[4 * j4 + 2] * nk[2]; g3 += SG[4 * j4 + 3] * nk[3];
                if ((j4 & 3) == 3) asm volatile("" ::: "memory");
            }
            const float saA = (a0 + a1) + (a2 + a3), saG = (g0 + g1) + (g2 + g3);
            float ya0 = 0.f, ya1 = 0.f, yg0 = 0.f, yg1 = 0.f;
#pragma unroll
            for (int j4 = 0; j4 < 16; ++j4) {
                const f32x4 w4 = p[16 + j4], b4 = p[32 + j4], k4 = p[48 + j4], r4 = p[64 + j4];
#pragma unroll
                for (int e = 0; e < 4; ++e) {
                    const int j = 4 * j4 + e;
                    SA[j] = SA[j] * w4[e] + saA * b4[e];
                    SG[j] = SG[j] * w4[e] + saG * b4[e] + vi * k4[e];
                    if (e & 1) { ya1 += SA[j] * r4[e]; yg1 += SG[j] * r4[e]; } else { ya0 += SA[j] * r4[e]; yg0 += SG[j] * r4[e]; }
                }
                if (j4 & 1) asm volatile("" ::: "memory");
            }
            const size_t oidx = (size_t)ch * 4096 + (sg * 8 + s) * 64 + lane;
            QC[oidx] = (bf16)f2bf(ya0 + ya1); YH[oidx] = (bf16)f2bf(yg0 + yg1);
        }
    }
    float* ap = AC + (size_t)ch * 4096 + lane * 64; float* gp = GC + (size_t)ch * 4096 + lane * 64;
#pragma unroll
    for (int j4 = 0; j4 < 16; ++j4) {
        *(f32x4*)(ap + 4 * j4) = (f32x4){SA[4 * j4], SA[4 * j4 + 1], SA[4 * j4 + 2], SA[4 * j4 + 3]};
        *(f32x4*)(gp + 4 * j4) = (f32x4){SG[4 * j4], SG[4 * j4 + 1], SG[4 * j4 + 2], SG[4 * j4 + 3]};
    }
}

__device__ __forceinline__ void r3_unit(const Frame& F, const Args& A, int bh, int rg) {
    unsigned char* ws = A.ws;
    const float* AC = A.out; const float* GC = A.out + (size_t)2048 * 4096; float* SALL = (float*)(ws + WS_SALL);
    LAS float* Sl = (LAS float*)F.lds;
    const int lane = F.lane, lr = lane & 15, lq = lane >> 4, ct = F.wave;
    __syncthreads();
    for (int i = F.tid; i < 2 * 16 * 66; i += 512) Sl[i] = 0.f;
    __syncthreads();
    int cur = 0;
    for (int c = 0; c < 31; ++c) {
        const int ch = bh * 32 + c;
        if (ct < 4) {
            const float* Ap = AC + (size_t)ch * 4096; const float* Gp = GC + (size_t)ch * 4096;
            float Bf[16];
#pragma unroll
            for (int kk = 0; kk < 16; ++kk) Bf[kk] = Ap[(4 * kk + lq) * 64 + 16 * ct + lr];
            f32x4 acc;
#pragma unroll
            for (int rg_ = 0; rg_ < 4; ++rg_) acc[rg_] = Gp[(16 * rg + 4 * lq + rg_) * 64 + 16 * ct + lr];
            const LAS float* Sc = Sl + cur * (16 * 66);
#pragma unroll
            for (int kk = 0; kk < 16; ++kk) acc = __builtin_amdgcn_mfma_f32_16x16x4f32(Sc[lr * 66 + 4 * kk + lq], Bf[kk], acc, 0, 0, 0);
            LAS float* Sn = Sl + (cur ^ 1) * (16 * 66);
            float* So = SALL + (size_t)(ch + 1) * 4096;
#pragma unroll
            for (int rg_ = 0; rg_ < 4; ++rg_) { Sn[(4 * lq + rg_) * 66 + 16 * ct + lr] = acc[rg_]; So[(16 * rg + 4 * lq + rg_) * 64 + 16 * ct + lr] = acc[rg_]; }
        }
        __syncthreads();
        cur ^= 1;
    }
}

__device__ __forceinline__ void r4_pair(const Frame& F, const Args& A, int chbase) {
    unsigned char* ws = A.ws;
    const bf16* QC = (const bf16*)(ws + WS_QC); const bf16* YH = (const bf16*)(ws + WS_YH); const float* SALL = (const float*)(ws + WS_SALL);
    const bf16* BON = (const bf16*)(ws + WS_BON); const bf16* GG = (const bf16*)(ws + WS_LORA) + (size_t)2 * NTOK * 1024; bf16* YA = (bf16*)(ws + WS_YAB);
    const float* lnw = A.in[12]; const float* lnb = A.in[13];
    const int lane = F.lane, lr = lane & 15, lq = lane >> 4, half = F.wave >> 2, st = F.wave & 3;
    const int ch = chbase + half, c = ch & 31, bh = ch >> 5, b = bh >> 4, h = bh & 15;
    LAS float* Qf = (LAS float*)F.lds + half * (2 * 64 * 66); LAS float* Sf = Qf + 64 * 66;
    __syncthreads();
    for (int idx = F.tid & 255; idx < 4096; idx += 256) {
        const int s = idx >> 6, k = idx & 63;
        Qf[s * 66 + k] = bf2f(QC[(size_t)ch * 4096 + idx]);
        Sf[s * 66 + k] = (c == 0) ? 0.f : SALL[(size_t)ch * 4096 + idx];
    }
    __syncthreads();
    f32x4 acc[4];
#pragma unroll
    for (int it = 0; it < 4; ++it)
#pragma unroll
        for (int rg_ = 0; rg_ < 4; ++rg_) acc[it][rg_] = bf2f(YH[(size_t)ch * 4096 + (16 * st + 4 * lq + rg_) * 64 + 16 * it + lr]);
#pragma unroll
    for (int kk = 0; kk < 16; ++kk) {
        const float a = Qf[(16 * st + lr) * 66 + 4 * kk + lq];
#pragma unroll
        for (int it = 0; it < 4; ++it) acc[it] = __builtin_amdgcn_mfma_f32_16x16x4f32(a, Sf[(16 * it + lr) * 66 + 4 * kk + lq], acc[it], 0, 0, 0);
    }
#pragma unroll
    for (int rg_ = 0; rg_ < 4; ++rg_) {
        float s = (acc[0][rg_] + acc[1][rg_]) + (acc[2][rg_] + acc[3][rg_]);
        s += __shfl_xor(s, 1); s += __shfl_xor(s, 2); s += __shfl_xor(s, 4); s += __shfl_xor(s, 8);
        const float mean = s * (1.f / 64.f);
        float d[4], q = 0.f;
#pragma unroll
        for (int it = 0; it < 4; ++it) { d[it] = acc[it][rg_] - mean; q += d[it] * d[it]; }
        q += __shfl_xor(q, 1); q += __shfl_xor(q, 2); q += __shfl_xor(q, 4); q += __shfl_xor(q, 8);
        const float rstd = rsqrtf(q * (1.f / 64.f) + 64e-5f);
        const size_t row = (size_t)b * SEQ + c * 64 + 16 * st + 4 * lq + rg_;
#pragma unroll
        for (int it = 0; it < 4; ++it) {
            const int col = h * 64 + 16 * it + lr;
            float y = d[it] * rstd * lnw[col] + lnb[col];
            y = (y + bf2f(BON[row * 1024 + col])) * bf2f(GG[row * 1024 + col]);
            YA[row * 1024 + col] = (bf16)f2bf(y);
        }
    }
}

__device__ __forceinline__ int crow(int r, int hi) { return (r & 3) + 8 * (r >> 2) + 4 * hi; }
constexpr int NSA_KS = 0, NSA_VS = 8192, NSA_WSF = 16384, NSA_IMP = 17408, NSA_MASK = 17408 + 64 * 33 * 4, NSA_ANY = NSA_MASK + 256, NSA_QF = 32768, NSA_OST = 65536;

__device__ __forceinline__ u32x4 nsa_ldk(const bf16* Kg, int ld, int key0, int tid) { return *(const u32x4*)(Kg + (size_t)(key0 + (tid & 63)) * ld + (tid >> 6) * 8); }
__device__ __forceinline__ u32x4 nsa_ldv(const bf16* Vg, int ld, int key0, int tid) { const int w8 = tid >> 6, lane = tid & 63; return *(const u32x4*)(Vg + (size_t)(key0 + 16 * (w8 & 3) + (lane >> 2)) * ld + (w8 >> 2) * 32 + (lane & 3) * 8); }
__device__ __forceinline__ s16x4 nsa_vtr(const LAS unsigned char* p) { typedef short v4i16_t __attribute__((ext_vector_type(4))); return __builtin_bit_cast(s16x4, __builtin_amdgcn_ds_read_tr16_b64_v4i16((LAS v4i16_t*)p)); }

__device__ __forceinline__ void nsa_qk(f32x16& p0, f32x16& p1, const LAS unsigned char* ks, const LAS unsigned char* qf, int r32, int hi) {
    const LAS unsigned char* kb = ks + hi * 1024 + r32 * 16;
    p0 = (f32x16){}; p1 = (f32x16){};
#pragma unroll
    for (int d0 = 0; d0 < 4; ++d0) {
        const bf16x8 b0 = *(const LAS bf16x8*)(kb + d0 * 2048), b1 = *(const LAS bf16x8*)(kb + d0 * 2048 + 512), q = *(const LAS bf16x8*)(qf + d0 * 1024);
        p0 = __builtin_amdgcn_mfma_f32_32x32x16_bf16(b0, q, p0, 0, 0, 0);
        p1 = __builtin_amdgcn_mfma_f32_32x32x16_bf16(b1, q, p1, 0, 0, 0);
    }
}
__device__ __forceinline__ void nsa_pv(f32x16 (&o)[2], const f32x16& p0, const f32x16& p1, const LAS unsigned char* vs, int lane, int hi) {
    bf16x8 pa[4];
#pragma unroll
    for (int k = 0; k < 4; ++k) {
        u32x4 w;
#pragma unroll
        for (int e = 0; e < 4; ++e) { const int r = (k & 1) * 8 + 2 * e; w[e] = (k < 2) ? pk2(p0[r], p0[r + 1]) : pk2(p1[r], p1[r + 1]); }
        pa[k] = __builtin_bit_cast(bf16x8, w);
    }
    const LAS unsigned char* vb = vs + ((lane >> 4) & 1) * 32 + (lane & 3) * 8 + (4 * hi + ((lane & 15) >> 2)) * 64;
#pragma unroll
    for (int dh = 0; dh < 2; ++dh)
#pragma unroll
        for (int k = 0; k < 4; ++k) {
            const s16x4 lo = nsa_vtr(vb + dh * 4096 + k * 1024), hi4 = nsa_vtr(vb + dh * 4096 + k * 1024 + 512);
            const bf16x8 vf = (bf16x8){lo[0], lo[1], lo[2], lo[3], hi4[0], hi4[1], hi4[2], hi4[3]};
            o[dh] = __builtin_amdgcn_mfma_f32_32x32x16_bf16(pa[k], vf, o[dh], 0, 0, 0);
        }
}
template <bool INIT>
__device__ __forceinline__ void nsa_accum(LAS float* ost, const f32x16 (&o)[2], float f, LAS float* wsf, int lane, int r32, int hi) {
    if (hi == 0) wsf[r32] = f;
    LDS_WAIT(); asm volatile("" ::: "memory");
#pragma unroll
    for (int r = 0; r < 16; ++r) {
        const float a = wsf[crow(r, hi)];
        if (INIT) { ost[r * 64 + lane] = a * o[0][r]; ost[(16 + r) * 64 + lane] = a * o[1][r]; }
        else { ost[r * 64 + lane] += a * o[0][r]; ost[(16 + r) * 64 + lane] += a * o[1][r]; }
    }
    LDS_WAIT(); asm volatile("" ::: "memory");
}

template <int MODE>
__device__ __forceinline__ void nsa_branch(const bf16* Kg, const bf16* Vg, int jlo, int jhi, unsigned anymask, unsigned mymask, int t, float slope,
                                           LAS unsigned char* lds, int tid, int lane, f32x16 (&o)[2], float& l_out) {
    const int r32 = lane & 31, hi = lane >> 5, wid = tid >> 6;
    LAS float* wsf = (LAS float*)(lds + NSA_WSF) + wid * 32;
    const LAS unsigned char* qf = lds + NSA_QF + wid * 4096 + lane * 16;
    float m = -1e30f, l = 0.f; o[0] = (f32x16){}; o[1] = (f32x16){};
    int j = jlo;
    if (MODE == 2) while (j <= jhi && !((anymask >> j) & 1u)) ++j;
    if (j > jhi) { l_out = 0.f; return; }
    u32x4 kreg = nsa_ldk(Kg, ZN_LD, 64 * j, tid), vreg = nsa_ldv(Vg, ZN_LD, 64 * j, tid);
    __syncthreads();
    *(LAS u32x4*)(lds + NSA_KS + tid * 16) = kreg; *(LAS u32x4*)(lds + NSA_VS + tid * 16) = vreg;
    __syncthreads();
    for (;;) {
        int jn = j + 1;
        if (MODE == 2) while (jn <= jhi && !((anymask >> jn) & 1u)) ++jn;
        const bool hn = jn <= jhi;
        if (hn) { kreg = nsa_ldk(Kg, ZN_LD, 64 * jn, tid); vreg = nsa_ldv(Vg, ZN_LD, 64 * jn, tid); }
        f32x16 p0, p1;
        nsa_qk(p0, p1, lds + NSA_KS, qf, r32, hi);
        const bool sel = (MODE == 2) ? (((mymask >> j) & 1u) != 0u) : true;
        const int pos0 = 64 * j;
        float mx = -1e30f;
#pragma unroll
        for (int r = 0; r < 16; ++r) {
            const int d0 = t - (pos0 + crow(r, hi)), d1 = d0 - 32;
            const bool v0 = sel && d0 >= 0 && (MODE == 1 ? d0 < 512 : true), v1 = sel && d1 >= 0 && (MODE == 1 ? d1 < 512 : true);
            const float s0 = v0 ? (p0[r] * 0.125f - slope * (float)d0) : -1e30f, s1 = v1 ? (p1[r] * 0.125f - slope * (float)d1) : -1e30f;
            p0[r] = s0; p1[r] = s1; mx = fmaxf(mx, fmaxf(s0, s1));
        }
        mx = fmaxf(mx, __shfl_xor(mx, 32));
        const float mn = fmaxf(m, mx), alpha = __expf(m - mn);
        float ps = 0.f;
#pragma unroll
        for (int r = 0; r < 16; ++r) {
            const float e0 = (p0[r] > -0.5e30f) ? __expf(p0[r] - mn) : 0.f, e1 = (p1[r] > -0.5e30f) ? __expf(p1[r] - mn) : 0.f;
            p0[r] = e0; p1[r] = e1; ps += e0 + e1;
        }
        ps += __shfl_xor(ps, 32);
        l = l * alpha + ps; m = mn;
        if (__any(alpha != 1.f)) {
            if (hi == 0) wsf[r32] = alpha;
            LDS_WAIT(); asm volatile("" ::: "memory");
#pragma unroll
            for (int r = 0; r < 16; ++r) { const float a = wsf[crow(r, hi)]; o[0][r] *= a; o[1][r] *= a; }
            LDS_WAIT(); asm volatile("" ::: "memory");
        }
        nsa_pv(o, p0, p1, lds + NSA_VS, lane, hi);
        __syncthreads();
        if (!hn) break;
        *(LAS u32x4*)(lds + NSA_KS + tid * 16) = kreg; *(LAS u32x4*)(lds + NSA_VS + tid * 16) = vreg;
        __syncthreads();
        j = jn;
    }
    l_out = l;
}

__device__ __forceinline__ void nsa_unit(const Frame& F, const Args& A, int b, int g, int qb) {
    unsigned char* ws = A.ws;
    const bf16* ZN = (const bf16*)(ws + WS_ZN); const bf16* KC = (const bf16*)(ws + WS_KCV); const bf16* VC = KC + 16 * 128 * 64; bf16* YB = (bf16*)(ws + WS_YAB) + (size_t)NTOK * 1024;
    LAS unsigned char* lds = F.lds;
    int lane_o = F.lane; asm volatile("" : "+v"(lane_o));
    const int wid = F.wave, lane = lane_o, tid = wid * 64 + lane, r32 = lane & 31, hi = lane >> 5, hg = r32 >> 3, ti = r32 & 7;
    const int tok = wid * 8 + ti, t = qb * 64 + tok, h = g * 4 + hg;
    const size_t row = (size_t)b * SEQ + t;
    const float slope = exp2f(-0.5f * (float)(h + 1));
    LAS float* wsf = (LAS float*)(lds + NSA_WSF) + wid * 32;
    LAS float* IMP = (LAS float*)(lds + NSA_IMP); LAS unsigned* MASK = (LAS unsigned*)(lds + NSA_MASK); LAS unsigned* ANYW = (LAS unsigned*)(lds + NSA_ANY);
    LAS unsigned char* qf = lds + NSA_QF + wid * 4096 + lane * 16;
    LAS float* ost = (LAS float*)(lds + NSA_OST) + wid * 2048;
    __syncthreads();
#pragma unroll
    for (int d0 = 0; d0 < 4; ++d0) *(LAS bf16x8*)(qf + d0 * 1024) = *(const bf16x8*)(ZN + row * ZN_LD + ZN_Q + h * 64 + d0 * 16 + hi * 8);
    const float gcmp = sigmoidf_(bf2f(ZN[row * ZN_LD + ZN_GATE + h])), gslc = sigmoidf_(bf2f(ZN[row * ZN_LD + ZN_GATE + 16 + h])), gwin = sigmoidf_(bf2f(ZN[row * ZN_LD + ZN_GATE + 32 + h]));
    {
        const bf16* KCb = KC + (size_t)(b * 4 + g) * 128 * 64; const bf16* VCb = VC + (size_t)(b * 4 + g) * 128 * 64;
        __syncthreads();
        *(LAS u32x4*)(lds + NSA_KS + tid * 16) = nsa_ldk(KCb, 64, 0, tid); *(LAS u32x4*)(lds + NSA_VS + tid * 16) = nsa_ldk(KCb, 64, 64, tid);
        __syncthreads();
        f32x16 a0, a1, b0, b1;
        nsa_qk(a0, a1, lds + NSA_KS, qf, r32, hi); nsa_qk(b0, b1, lds + NSA_VS, qf, r32, hi);
        {
            const u32x4 v0r = nsa_ldv(VCb, 64, 0, tid), v1r = nsa_ldv(VCb, 64, 64, tid);
            __syncthreads();
            *(LAS u32x4*)(lds + NSA_KS + tid * 16) = v0r; *(LAS u32x4*)(lds + NSA_VS + tid * 16) = v1r;
        }
        float mx = -1e30f;
#pragma unroll
        for (int r = 0; r < 16; ++r) {
            const int n = crow(r, hi);
            const int d00 = t - (16 * n + 31), d01 = d00 - 512, d10 = d00 - 1024, d11 = d00 - 1536;
            a0[r] = d00 >= 0 ? (a0[r] * 0.125f - slope * (float)d00) : -1e30f; a1[r] = d01 >= 0 ? (a1[r] * 0.125f - slope * (float)d01) : -1e30f;
            b0[r] = d10 >= 0 ? (b0[r] * 0.125f - slope * (float)d10) : -1e30f; b1[r] = d11 >= 0 ? (b1[r] * 0.125f - slope * (float)d11) : -1e30f;
            mx = fmaxf(fmaxf(mx, fmaxf(a0[r], a1[r])), fmaxf(b0[r], b1[r]));
        }
        mx = fmaxf(mx, __shfl_xor(mx, 32));
        float ps = 0.f;
#pragma unroll
        for (int r = 0; r < 16; ++r) {
            a0[r] = (a0[r] > -0.5e30f) ? __expf(a0[r] - mx) : 0.f; a1[r] = (a1[r] > -0.5e30f) ? __expf(a1[r] - mx) : 0.f;
            b0[r] = (b0[r] > -0.5e30f) ? __expf(b0[r] - mx) : 0.f; b1[r] = (b1[r] > -0.5e30f) ? __expf(b1[r] - mx) : 0.f;
            ps += (a0[r] + a1[r]) + (b0[r] + b1[r]);
        }
        ps += __shfl_xor(ps, 32);
        const float inv = 1.f / fmaxf(ps, 1e-30f);
#pragma unroll
        for (int r = 0; r < 16; ++r) { a0[r] *= inv; a1[r] *= inv; b0[r] *= inv; b1[r] *= inv; }
        float cprev = 0.f;
#pragma unroll
        for (int kk = 0; kk < 16; ++kk) {
            const int k = kk & 3, X = (kk >> 2) & 1, T = kk >> 3;
            float x0, x1, x2, x3;
            if (T == 0 && X == 0) { x0 = a0[4 * k]; x1 = a0[4 * k + 1]; x2 = a0[4 * k + 2]; x3 = a0[4 * k + 3]; }
            else if (T == 0) { x0 = a1[4 * k]; x1 = a1[4 * k + 1]; x2 = a1[4 * k + 2]; x3 = a1[4 * k + 3]; }
            else if (X == 0) { x0 = b0[4 * k]; x1 = b0[4 * k + 1]; x2 = b0[4 * k + 2]; x3 = b0[4 * k + 3]; }
            else { x0 = b1[4 * k]; x1 = b1[4 * k + 1]; x2 = b1[4 * k + 2]; x3 = b1[4 * k + 3]; }
            float av = (x0 + x1) + (x2 + 0.5f * x3), cv = 0.5f * x3;
            av += __shfl_xor(av, 8); av += __shfl_xor(av, 16); cv += __shfl_xor(cv, 8); cv += __shfl_xor(cv, 16);
            const float cp = __shfl_xor(cv, 32);
            const float impj = av + (hi ? cp : cprev);
            cprev = cp;
            if (hg == 0) IMP[tok * 33 + 2 * kk + hi] = impj;
        }
        __syncthreads();
        f32x16 oc[2]; oc[0] = (f32x16){}; oc[1] = (f32x16){};
        nsa_pv(oc, a0, a1, lds + NSA_KS, lane, hi); nsa_pv(oc, b0, b1, lds + NSA_VS, lane, hi);
        nsa_accum<true>(ost, oc, gcmp, wsf, lane, r32, hi);
        {
            int tid_o = tid; asm volatile("" : "+v"(tid_o));
            const int tk = tid_o >> 3, jq = tid_o & 7; unsigned bits = 0u;
            float sc[32];
#pragma unroll
            for (int jj = 0; jj < 32; ++jj) sc[jj] = (jj > qb) ? -1e30f : ((jj == 0 || jj == qb || jj == qb - 1) ? 1e30f : IMP[tk * 33 + jj]);
#pragma unroll
            for (int e = 0; e < 4; ++e) {
                const int j = jq * 4 + e;
                const float sj = (j > qb) ? -1e30f : ((j == 0 || j == qb || j == qb - 1) ? 1e30f : IMP[tk * 33 + j]);
                int cnt = 0;
#pragma unroll
                for (int jj = 0; jj < 32; ++jj) cnt += (sc[jj] > sj || (sc[jj] == sj && jj < j)) ? 1 : 0;
                if (cnt < 16 && sj > -0.5e30f) bits |= 1u << j;
            }
            bits |= __shfl_xor(bits, 1); bits |= __shfl_xor(bits, 2); bits |= __shfl_xor(bits, 4);
            if (jq == 0) MASK[tk] = bits;
        }
        __syncthreads();
        if (tid < 64) { unsigned v = MASK[tid]; v |= __shfl_xor(v, 1); v |= __shfl_xor(v, 2); v |= __shfl_xor(v, 4); v |= __shfl_xor(v, 8); v |= __shfl_xor(v, 16); v |= __shfl_xor(v, 32); if (tid == 0) ANYW[0] = v; }
        __syncthreads();
    }
    f32x16 o[2];
    const unsigned mymask = MASK[tok], anymask = ANYW[0];
    float lb;
#ifndef NSA_NO_WIN
    {
        const bf16* Kg = ZN + (size_t)b * SEQ * ZN_LD + ZN_KW + g * 64; const bf16* Vg = ZN + (size_t)b * SEQ * ZN_LD + ZN_VW + g * 64;
        nsa_branch<1>(Kg, Vg, qb >= 8 ? qb - 8 : 0, qb, 0u, 0u, t, slope, lds, tid, lane, o, lb);
        nsa_accum<false>(ost, o, gwin / fmaxf(lb, 1e-30f), wsf, lane, r32, hi);
    }
#endif
#ifndef NSA_NO_SEL
    {
        const bf16* Kg = ZN + (size_t)b * SEQ * ZN_LD + ZN_KS + g * 64; const bf16* Vg = ZN + (size_t)b * SEQ * ZN_LD + ZN_VS + g * 64;
        nsa_branch<2>(Kg, Vg, 0, qb, anymask, mymask, t, slope, lds, tid, lane, o, lb);
        nsa_accum<false>(ost, o, gslc / fmaxf(lb, 1e-30f), wsf, lane, r32, hi);
    }
#endif
    {
        int lane_s = lane; asm volatile("" : "+v"(lane_s));
        const int his = lane_s >> 5;
#pragma unroll
        for (int r = 0; r < 16; ++r) {
            const int q = crow(r, his), tq = qb * 64 + wid * 8 + (q & 7), hq = g * 4 + (q >> 3);
            bf16* dst = YB + ((size_t)b * SEQ + tq) * 1024 + hq * 64 + (lane_s & 31);
            dst[0] = (bf16)f2bf(ost[r * 64 + lane_s]); dst[32] = (bf16)f2bf(ost[(16 + r) * 64 + lane_s]);
        }
    }
}

constexpr int N_PHASES = 12;
template <int PHM> __global__ void __launch_bounds__(512, 2) mega_fwd(Args args) {
    extern __shared__ __attribute__((aligned(16))) unsigned char lds_raw[];
    Frame F;
    F.lds = (LAS unsigned char*)lds_raw;
    F.tid = threadIdx.x; F.lane = F.tid & 63; F.wave = __builtin_amdgcn_readfirstlane(F.tid >> 6);
    F.G = gridDim.x; { const int bx = blockIdx.x; F.vcu = (F.G % 8 == 0) ? (bx % 8) * (F.G / 8) + bx / 8 : bx; }
    F.in = nullptr;
    unsigned char* ws = args.ws;
    volatile LAS unsigned* MISC = (volatile LAS unsigned*)(F.lds + MISC_OFF);
    for (int u = F.tid; u < (LDS_BYTES - LDSCTL_OFF) / 4; u += 512) ((LAS unsigned*)(F.lds + LDSCTL_OFF))[u] = 0u;
    __syncthreads();
#if MK_ONE_LAUNCH
    XcdBarrier bar = xcd_barrier_post((unsigned*)(ws + WS_CTL) + CW_BAR, MISC + 8, F.tid);
#define GRID_BAR() do { PHASE_FRAME(); xcd_barrier(bar, Fp.tid); } while (0)
#else
#define GRID_BAR() do { } while (0)
#endif
    const int lo = args.ph_lo, hi = args.ph_hi;
#ifdef TPROBE_LO
    unsigned long long tp0_ = 0ull, tp1_ = 0ull;
#define TP(k) do { if ((k) == TPROBE_LO) tp0_ = __builtin_amdgcn_s_memrealtime(); if ((k) == TPROBE_HI) tp1_ = __builtin_amdgcn_s_memrealtime(); } while (0)
#else
#define TP(k) do { } while (0)
#endif
#define PHASE_FRAME() Frame Fp = F; asm volatile("v_mbcnt_lo_u32_b32 %0, -1, 0\n\tv_mbcnt_hi_u32_b32 %0, -1, %0" : "=v"(Fp.lane)); asm volatile("" : "+s"(Fp.wave), "+s"(Fp.vcu)); Fp.tid = Fp.wave * 64 + Fp.lane
#define IN(k) (((PHM >> (k)) & 1) && lo <= (k) && (k) < hi)
#define SEAM(k) do { if (IN(k) && IN((k) + 1)) GRID_BAR(); } while (0)

    bf16* ZR = (bf16*)(ws + WS_ZR); bf16* ZN = (bf16*)(ws + WS_ZN); bf16* ZG = (bf16*)(ws + WS_ZG);
    float* rowsq1 = (float*)(ws + WS_CTL + CTL_ROWSQ1); float* rowsq2 = (float*)(ws + WS_CTL + CTL_ROWSQ2);

    TP(0);
    if (IN(0)) { PHASE_FRAME(); ph0_prologue(Fp, args); }
    SEAM(0);
    TP(1);
    if (IN(1)) {
        pg8::Gemm g{(const pg8::bf16_t*)(ws + WS_XN), (const pg8::bf16_t*)(ws + WS_WINT), NTOK, INCP, 2048};
        pg8::StaticOrder S; S.init(NTOK, INCP, F.G, (int)blockIdx.x);
        EpiProj E{ZR, ZN, ZG};
        pg8::gemm_phase<EpiProj, pg8::StaticOrder, true, true>(F.lds, g, S, E, F.wave);
    }
    SEAM(1);
    TP(2);
    if (IN(2)) { PHASE_FRAME(); ph2_build(Fp, args); }
    SEAM(2);
    TP(3);
    if (IN(3)) {
#ifndef NO_LORAGEMM
        {
            int kl = 256; asm volatile("" : "+s"(kl));
            pg8::Gemm g{(const pg8::bf16_t*)(ws + WS_A2), (const pg8::bf16_t*)(ws + WS_LORAT), 3 * NTOK, 3 * 1024, kl};
            CatOrder<32, 4, 3> S; S.init(F.G, (int)blockIdx.x);
            EpiLora E{(bf16*)(ws + WS_LORA), args.in[4], args.in[6]};
            pg8::gemm_phase<EpiLora, CatOrder<32, 4, 3>, true, true>(F.lds, g, S, E, F.wave);
        }
#endif
#ifndef NO_CMPGEMM
        {
            pg8::Gemm g{(const pg8::bf16_t*)(ws + WS_AG), (const pg8::bf16_t*)(ws + WS_W1T), 8 * 2048, 8 * 256, 512};
            int c2 = (int)((blockIdx.x + 64) % F.G); float* hp = (float*)(ws + WS_HPART);
            asm volatile("" : "+s"(c2), "+s"(hp));
            CatOrder<8, 1, 8> S; S.init(F.G, c2);
            EpiHpart E{hp};
            pg8::gemm_phase<EpiHpart, CatOrder<8, 1, 8>, true, true>(F.lds, g, S, E, F.wave);
        }
#endif
    }
    SEAM(3);
    TP(4);
    if (IN(4)) {
        { PHASE_FRAME(); for (int u = Fp.vcu; u < 128; u += Fp.G) cmp_finish_unit(Fp, args, u); }
        __syncthreads();
        { PHASE_FRAME(); LAS float* wl = (LAS float*)(Fp.lds + Fp.wave * 12288);
          for (int ch = Fp.vcu * 8 + Fp.wave; ch < 2048; ch += Fp.G * 8) scan_chunk(Fp, args, ch, wl); }
    }
    SEAM(4);
    TP(5);
    if (IN(5)) {
#ifndef NO_R3
        { PHASE_FRAME(); for (int u = Fp.vcu; u < 256; u += Fp.G) r3_unit(Fp, args, u >> 2, u & 3); }
#endif
        __syncthreads();
        PHASE_FRAME();
        for (int p = Fp.vcu; p < 256; p += Fp.G) {
            const int bg = p >> 4, s = p & 15;
#ifndef NO_NSA
#pragma unroll 1
            for (int k2 = 0; k2 < 2; ++k2) nsa_unit(Fp, args, bg >> 2, bg & 3, k2 ? s : 31 - s);
#endif
        }
    }
    SEAM(5);
    TP(6);
    if (IN(6)) {
        { PHASE_FRAME(); for (int cp = Fp.vcu; cp < 1024; cp += Fp.G) r4_pair(Fp, args, 2 * cp); }
        __syncthreads();
        { PHASE_FRAME(); ph_cvt_mlp(Fp, args); }
    }
    SEAM(6);
    TP(7);
    if (IN(7)) {
        pg8::Gemm g{(const pg8::bf16_t*)(ws + WS_YAB), (const pg8::bf16_t*)(ws + WS_WOUTT), 2 * NTOK, 2 * 2048, 1024};
        PairOrder<32, 8> S; S.init(F.G, (int)blockIdx.x);
        EpiMerge E{ZG, (bf16*)(ws + WS_MIXED)};
        pg8::gemm_phase<EpiMerge, PairOrder<32, 8>, false, true>(F.lds, g, S, E, F.wave);
    }
    SEAM(7);
    TP(8);
    if (IN(8)) {
        pg8::Gemm g{(const pg8::bf16_t*)(ws + WS_MIXED), (const pg8::bf16_t*)(ws + WS_WOT), NTOK, 2048, 2048};
        pg8::StaticOrder S; S.init(NTOK, 2048, F.G, (int)blockIdx.x);
        EpiWo E{args.in[0], args.out, (bf16*)(ws + WS_H1B), rowsq1};
        pg8::gemm_phase<EpiWo, pg8::StaticOrder, false, true>(F.lds, g, S, E, F.wave);
    }
    SEAM(8);
    TP(9);
    if (IN(9)) {
        pg8::Gemm g{(const pg8::bf16_t*)(ws + WS_H1B), (const pg8::bf16_t*)(ws + WS_UPT), NTOK, DFF, 2048};
        pg8::StaticOrder S; S.init(NTOK, DFF, F.G, (int)blockIdx.x);
        EpiUp E{rowsq1, (bf16*)(ws + WS_ACT)};
        pg8::gemm_phase<EpiUp, pg8::StaticOrder, true, true>(F.lds, g, S, E, F.wave);
    }
    SEAM(9);
    TP(10);
    if (IN(10)) {
        pg8::Gemm g{(const pg8::bf16_t*)(ws + WS_ACT), (const pg8::bf16_t*)(ws + WS_DOWNT), NTOK, 2048, DFF};
        pg8::StaticOrder S; S.init(NTOK, 2048, F.G, (int)blockIdx.x);
        EpiDown E{args.out, rowsq2};
        pg8::gemm_phase<EpiDown, pg8::StaticOrder, false, true>(F.lds, g, S, E, F.wave);
    }
    SEAM(10);
    TP(11);
    if (IN(11)) {
        PHASE_FRAME();
        const float* nf = args.in[26];
        const int gw = Fp.vcu * 8 + Fp.wave, NGW = Fp.G * 8;
        for (int m = gw; m < NTOK; m += NGW) {
            const float rs = rsqrtf(__hip_atomic_load(rowsq2 + m, __ATOMIC_RELAXED, __HIP_MEMORY_SCOPE_AGENT) * (1.f / DM) + 1e-5f);
            f32x4* o = (f32x4*)(args.out + (size_t)m * DM) + Fp.lane;
#pragma unroll
            for (int j = 0; j < 8; ++j) { const f32x4 g = *((const f32x4*)nf + Fp.lane + 64 * j); f32x4 v = o[64 * j]; v = v * rs * g; o[64 * j] = v; }
        }
    }
    TP(12);
#ifdef TPROBE_LO
    { const unsigned long long te_ = __builtin_amdgcn_s_memrealtime(), dl_ = (tp1_ - tp0_) * TPROBE_MUL;
      while (__builtin_amdgcn_s_memrealtime() - te_ < dl_) __builtin_amdgcn_s_sleep(8); }
#endif
#undef IN
#undef SEAM
}

typedef void (*kern_t)(Args);
extern "C" void kernel_launch(void* const* d_in, const int* in_sizes, int n_in, void* d_out, int out_size, void* d_ws, size_t ws_size, hipStream_t stream) {
    static int grid = 0;
#if MK_ONE_LAUNCH
    static const kern_t kerns[1] = { mega_fwd<0xFFF> };
    constexpr int NK = 1;
#else
    static const kern_t kerns[12] = { mega_fwd<1>, mega_fwd<2>, mega_fwd<4>, mega_fwd<8>, mega_fwd<16>, mega_fwd<32>, mega_fwd<64>, mega_fwd<128>, mega_fwd<256>, mega_fwd<512>, mega_fwd<1024>, mega_fwd<2048> };
    constexpr int NK = 12;
#endif
    if (grid == 0) {
        if (n_in != 27 || in_sizes[0] != NTOK * DM || out_size != NTOK * DM || ws_size < WS_END) { fprintf(stderr, "kernel_launch: unexpected problem shape / workspace (%d inputs, ws %zu)\n", n_in, ws_size); grid = -1; return; }
        int dev = 0, cus = 0, per_cu = 0;
        if (hipGetDevice(&dev) != hipSuccess || hipDeviceGetAttribute(&cus, hipDeviceAttributeMultiprocessorCount, dev) != hipSuccess) { grid = -1; return; }
        for (int k = 0; k < NK; ++k) {
            if (hipFuncSetAttribute((const void*)kerns[k], hipFuncAttributeMaxDynamicSharedMemorySize, LDS_BYTES) != hipSuccess) { grid = -1; return; }
            if (hipOccupancyMaxActiveBlocksPerMultiprocessor(&per_cu, (const void*)kerns[k], 512, LDS_BYTES) != hipSuccess || per_cu < 1) { fprintf(stderr, "kernel_launch: occupancy query reports %d blocks/CU\n", per_cu); grid = -1; (void)hipGetLastError(); return; }
        }
        grid = cus;
    }
    if (grid < 0) return;
    (void)hipMemsetAsync((char*)d_ws + WS_CTL, 0, CTL_ZERO_BYTES, stream);
    Args a{};
    for (int i = 0; i < 27; ++i) a.in[i] = (const float*)d_in[i];
    a.out = (float*)d_out; a.ws = (unsigned char*)d_ws;
#if MK_ONE_LAUNCH
    a.ph_lo = 0; a.ph_hi = N_PHASES; a.li = 0;
    hipLaunchKernelGGL(kerns[0], dim3(grid), dim3(512), LDS_BYTES, stream, a);
#else
    for (int p = 0; p < N_PHASES; ++p) { a.ph_lo = p; a.ph_hi = p + 1; a.li = p; hipLaunchKernelGGL(kerns[p], dim3(grid), dim3(512), LDS_BYTES, stream, a); }
#endif
}
```

```cpp
#include <hip/hip_runtime.h>
#include <cstdio>
#include <cstdint>

#ifndef MK_ONE_LAUNCH
#define MK_ONE_LAUNCH 1
#endif

namespace pg8 {
#define PG8_LAS __attribute__((address_space(3)))
typedef unsigned short bf16_t;
typedef short bf16x8 __attribute__((ext_vector_type(8)));
typedef float f32x4 __attribute__((ext_vector_type(4)));
typedef unsigned u32x4 __attribute__((ext_vector_type(4)));
constexpr int BM = 256, BK = 64, HALF = 128, HTB = HALF * BK * 2  , STAGE_BYTES = 8 * HTB, NXCD = 8, WGM = 8;

__host__ __device__ __forceinline__ int lds_byte(int r, int c) { const int st = (r >> 4) * 2 + (c >> 5), rr = r & 15, cc = c & 31, ob = rr * 64 + cc * 2; return st * 1024 + (ob ^ (((ob >> 9) & 1) << 5)); }
__host__ __device__ __forceinline__ void stage_rc(int b, int& R, int& C) { const int st = b / 1024, sb = b % 1024, swz = sb ^ (((sb >> 9) & 1) << 5); R = (st >> 1) * 16 + swz / 64; C = (st & 1) * 32 + (swz % 64) / 2; }
__host__ __device__ __forceinline__ int perm32(int rho) { const int n = rho >> 4, i = rho & 15; return 8 * (i >> 2) + 4 * n + (i & 3); }

struct Unit { int pm, pn; };
struct Gemm { const bf16_t* A; const bf16_t* Bt; int M, N, K; };

struct StaticOrder {
    int nM, nN, nwg, G, c;
    __host__ __device__ void init(int M, int N, int G_, int c_) { nM = M / BM; nN = N / BM; nwg = nM * nN; G = G_; c = c_; }
    __host__ __device__ bool next(int i, Unit& u) const {
        const long L = (long)i * G + c; if (L >= nwg) return false;
        int wgid = (int)L; { const int q = nwg / NXCD, r = nwg % NXCD, xcd = wgid % NXCD, off = wgid / NXCD; wgid = (xcd < r ? xcd * (q + 1) : r * (q + 1) + (xcd - r) * q) + off; }
        const int nig = WGM * nN, gid = wgid / nig, fm = gid * WGM, gsz = (nM - fm) < WGM ? (nM - fm) : WGM;
        u.pm = fm + ((wgid % nig) % gsz); u.pn = (wgid % nig) / gsz; return true;
    }
    __device__ __forceinline__ void a_ready(const Unit&) const {}
    __device__ __forceinline__ void done(const Unit&) const {}
};

template <class Epi, class Sched, bool ALIGN_EPI = false, bool SP2 = false>
__device__ __forceinline__ void gemm_phase(PG8_LAS unsigned char* lds, const Gemm g, const Sched& S, const Epi& E, int wave_id_) {
    int tid_o_; asm volatile("v_mbcnt_lo_u32_b32 %0, -1, 0\n\tv_mbcnt_hi_u32_b32 %0, -1, %0" : "=v"(tid_o_)); tid_o_ += wave_id_ * 64;
    const int tid = tid_o_, wid = __builtin_amdgcn_readfirstlane(tid >> 6), lane = tid & 63, wr = wid >> 2, wc = wid & 3, fr = lane & 15, fq = lane >> 4;
    const int K = g.K, nt = K / BK;
    unsigned voffA[2], voffB[2];
#pragma unroll
    for (int i = 0; i < 2; ++i) { int R, C; stage_rc(tid * 16 + i * 8192, R, C); const int Rb = Epi::PERM ? ((R & ~31) + perm32(R & 31)) : R;
        voffA[i] = (unsigned)(R * K + C) * 2u; voffB[i] = (unsigned)(Rb * K + C) * 2u; }
    const size_t kstep = (size_t)(BK * 2);
    const size_t hstep = (size_t)HALF * K * 2;
    const size_t tstep = 2 * hstep;
    const unsigned ldsw = (unsigned)wid * 1024u;
    const int aoff = lds_byte(wr * 64 + fr, fq * 8), boff = lds_byte(wc * 32 + fr, fq * 8);
#define PG8_SA(b, h) (((b) * 2 + (h)) * HTB)
#define PG8_SB(b, h) ((4 + (b) * 2 + (h)) * HTB)
#define PG8_STAGE(bufoff, gbase, voff) do { _Pragma("unroll") for (int _i = 0; _i < 2; ++_i) \
        __builtin_amdgcn_global_load_lds((const unsigned*)((const char*)(gbase) + (voff)[_i]), (PG8_LAS unsigned*)(lds + (bufoff) + ldsw + _i * 8192), 16, 0, 0); } while (0)
#define PG8_LDA(dst, b, h) do { _Pragma("unroll") for (int m = 0; m < 4; ++m) _Pragma("unroll") for (int k = 0; k < 2; ++k) dst[m][k] = *(const PG8_LAS bf16x8*)(lds + PG8_SA(b, h) + aoff + m * 2048 + k * 1024); } while (0)
#define PG8_LDB(dst, b, h) do { _Pragma("unroll") for (int n = 0; n < 2; ++n) _Pragma("unroll") for (int k = 0; k < 2; ++k) dst[n][k] = *(const PG8_LAS bf16x8*)(lds + PG8_SB(b, h) + boff + n * 2048 + k * 1024); } while (0)
#define PG8_MMA(ai, bj, At, Bt) do { __builtin_amdgcn_s_setprio(1); _Pragma("unroll") for (int m = 0; m < 4; ++m) _Pragma("unroll") for (int n = 0; n < 2; ++n) _Pragma("unroll") for (int k = 0; k < 2; ++k) \
        acc[ai][bj][m][n] = __builtin_amdgcn_mfma_f32_16x16x32_bf16(Bt[n][k], At[m][k], acc[ai][bj][m][n], 0, 0, 0); __builtin_amdgcn_s_setprio(0); } while (0)
#define PG8_WAIT_V(n) asm volatile("s_waitcnt vmcnt(" #n ")" ::: "memory")
#define PG8_WAIT_L(n) asm volatile("s_waitcnt lgkmcnt(" #n ")" ::: "memory")
#define PG8_BAR __builtin_amdgcn_s_barrier()
#define PG8_SCHED __builtin_amdgcn_sched_barrier(0)
    Unit cur, nxt; int ui = 0;
    if (!S.next(0, cur)) return;
    f32x4 acc[2][2][4][2];
#pragma unroll
    for (int a = 0; a < 2; ++a)
#pragma unroll
        for (int b = 0; b < 2; ++b)
#pragma unroll
            for (int m = 0; m < 4; ++m)
#pragma unroll
                for (int n = 0; n < 2; ++n) acc[a][b][m][n] = (f32x4){0.f, 0.f, 0.f, 0.f};
    bf16x8 At[4][2], B0[2][2], B1[2][2];
    const char* cA = (const char*)g.A + (size_t)cur.pm * tstep; const char* cB = (const char*)g.Bt + (size_t)cur.pn * tstep;
    S.a_ready(cur);
    if constexpr (SP2) {
        PG8_STAGE(PG8_SB(0, 0), cB, voffB); PG8_STAGE(PG8_SB(0, 1), cB + hstep, voffB); PG8_STAGE(PG8_SA(0, 0), cA, voffA); PG8_STAGE(PG8_SA(0, 1), cA + hstep, voffA);
        if (wr == 1) PG8_BAR;
        PG8_WAIT_V(2); PG8_BAR;
        PG8_STAGE(PG8_SB(1, 0), cB + kstep, voffB); PG8_STAGE(PG8_SA(1, 0), cA + kstep, voffA); PG8_STAGE(PG8_SB(1, 1), cB + hstep + kstep, voffB);
        PG8_WAIT_V(6); PG8_BAR;
    } else {
        PG8_STAGE(PG8_SB(0, 0), cB, voffB); PG8_STAGE(PG8_SA(0, 0), cA, voffA); PG8_STAGE(PG8_SB(0, 1), cB + hstep, voffB); PG8_STAGE(PG8_SA(0, 1), cA + hstep, voffA);
        if (wr == 1) PG8_BAR;
        PG8_WAIT_V(4); PG8_BAR;
        PG8_STAGE(PG8_SB(1, 0), cB + kstep, voffB); PG8_STAGE(PG8_SA(1, 0), cA + kstep, voffA); PG8_STAGE(PG8_SB(1, 1), cB + hstep + kstep, voffB);
        PG8_WAIT_V(6); PG8_BAR;
    }
    for (;;) {
        const bool has_next = S.next(ui + 1, nxt);
        const char* nA = has_next ? (const char*)g.A + (size_t)nxt.pm * tstep : cA; const char* nB = has_next ? (const char*)g.Bt + (size_t)nxt.pn * tstep : cB;
        for (int t = 0; t < nt; t += 2) {
            const bool last = (t == nt - 2);
            const char* a1 = cA + (size_t)(t + 1) * kstep;
            const char* a2 = last ? nA : cA + (size_t)(t + 2) * kstep; const char* b2 = last ? nB : cB + (size_t)(t + 2) * kstep;
            const char* a3 = a2 + kstep; const char* b3 = b2 + kstep;
            if (last && has_next) S.a_ready(nxt);
            if constexpr (SP2) {
            PG8_LDB(B0, 0, 0); PG8_LDB(B1, 0, 1); PG8_SCHED; PG8_LDA(At, 0, 0); PG8_STAGE(PG8_SA(1, 1), a1 + hstep, voffA);
            PG8_WAIT_V(8); PG8_WAIT_L(0); PG8_BAR; PG8_MMA(0, 0, At, B0); PG8_MMA(0, 1, At, B1); PG8_BAR; PG8_SCHED;
            PG8_LDA(At, 0, 1); PG8_STAGE(PG8_SB(0, 0), b2, voffB); PG8_STAGE(PG8_SB(0, 1), b2 + hstep, voffB); PG8_STAGE(PG8_SA(0, 0), a2, voffA);
            PG8_WAIT_V(8); PG8_WAIT_L(0); PG8_BAR; PG8_MMA(1, 0, At, B0); PG8_MMA(1, 1, At, B1); PG8_BAR; PG8_SCHED;
            PG8_LDB(B0, 1, 0); PG8_LDB(B1, 1, 1); PG8_SCHED; PG8_LDA(At, 1, 0); PG8_STAGE(PG8_SA(0, 1), a2 + hstep, voffA);
            PG8_WAIT_V(8); PG8_WAIT_L(0); PG8_BAR; PG8_MMA(0, 0, At, B0); PG8_MMA(0, 1, At, B1); PG8_BAR; PG8_SCHED;
            PG8_LDA(At, 1, 1); PG8_STAGE(PG8_SB(1, 0), b3, voffB); PG8_STAGE(PG8_SB(1, 1), b3 + hstep, voffB); PG8_STAGE(PG8_SA(1, 0), a3, voffA);
            PG8_WAIT_V(8); PG8_WAIT_L(0); PG8_BAR; PG8_MMA(1, 0, At, B0); PG8_MMA(1, 1, At, B1); PG8_BAR; PG8_SCHED;
            } else {
            PG8_LDB(B0, 0, 0); PG8_SCHED; PG8_LDA(At, 0, 0); PG8_STAGE(PG8_SA(1, 1), a1 + hstep, voffA);
            PG8_WAIT_L(8); PG8_BAR; PG8_WAIT_L(0); PG8_MMA(0, 0, At, B0); PG8_BAR; PG8_SCHED;
            PG8_LDB(B1, 0, 1); PG8_STAGE(PG8_SB(0, 0), b2, voffB);
            PG8_BAR; PG8_WAIT_L(0); PG8_MMA(0, 1, At, B1); PG8_BAR;
            PG8_LDA(At, 0, 1); PG8_STAGE(PG8_SA(0, 0), a2, voffA);
            PG8_BAR; PG8_WAIT_L(0); PG8_MMA(1, 0, At, B0); PG8_BAR; PG8_SCHED;
            PG8_STAGE(PG8_SB(0, 1), b2 + hstep, voffB);
            PG8_WAIT_V(6); PG8_BAR; PG8_MMA(1, 1, At, B1); PG8_BAR;
            PG8_LDB(B0, 1, 0); PG8_SCHED; PG8_LDA(At, 1, 0); PG8_STAGE(PG8_SA(0, 1), a2 + hstep, voffA);
            PG8_WAIT_L(8); PG8_BAR; PG8_WAIT_L(0); PG8_MMA(0, 0, At, B0); PG8_BAR; PG8_SCHED;
            PG8_LDB(B1, 1, 1); PG8_STAGE(PG8_SB(1, 0), b3, voffB);
            PG8_BAR; PG8_WAIT_L(0); PG8_MMA(0, 1, At, B1); PG8_BAR;
            PG8_LDA(At, 1, 1); PG8_STAGE(PG8_SA(1, 0), a3, voffA);
            PG8_BAR; PG8_WAIT_L(0); PG8_MMA(1, 0, At, B0); PG8_BAR; PG8_SCHED;
            PG8_STAGE(PG8_SB(1, 1), b3 + hstep, voffB);
            PG8_WAIT_V(6); PG8_BAR; PG8_MMA(1, 1, At, B1); PG8_BAR;
            }
        }
        if constexpr (ALIGN_EPI) { if (wr == 0) PG8_BAR; }
        if constexpr (Epi::CHAIN) { if ((ui & 1) == 0) E.mid(acc, cur, wr, wc, fr, fq); else E(acc, cur, wr, wc, fr, fq); }
        else if constexpr (!Epi::AFTER_DRAIN) { E(acc, cur, wr, wc, fr, fq); S.done(cur); }
        if (!has_next) break;
        const bool zero_acc_ = !Epi::CHAIN || (ui & 1) == 1;
#pragma unroll
        for (int a = 0; a < 2; ++a)
#pragma unroll
            for (int b = 0; b < 2; ++b)
#pragma unroll
                for (int m = 0; m < 4; ++m)
#pragma unroll
                    for (int n = 0; n < 2; ++n) if (zero_acc_) acc[a][b][m][n] = (f32x4){0.f, 0.f, 0.f, 0.f};
        cur = nxt; cA = nA; cB = nB; ++ui;
        if constexpr (ALIGN_EPI) { if (wr == 1) PG8_BAR; }
    }
    PG8_WAIT_V(0);
    if constexpr (!ALIGN_EPI) { if (wr == 0) PG8_BAR; }
    PG8_BAR;
    if constexpr (Epi::AFTER_DRAIN) { E.fused(acc, cur, wr, wc, fr, fq, lds, wid, lane); S.done(cur); }
#undef PG8_SA
#undef PG8_SB
#undef PG8_STAGE
#undef PG8_LDA
#undef PG8_LDB
#undef PG8_MMA
#undef PG8_WAIT_V
#undef PG8_WAIT_L
#undef PG8_BAR
#undef PG8_SCHED
}
}

constexpr int NTOK = 8192, SEQ = 2048, DM = 2048, NB = 4;
constexpr int ZR_LD = 3520, ZN_LD = 2608, ZG_LD = 4096, INC = 10224, INCP = 10240;
constexpr int DFF = 8192;
constexpr int ZN_Q = 0, ZN_KC = 1024, ZN_VC = 1280, ZN_KS = 1536, ZN_VS = 1792, ZN_KW = 2048, ZN_VW = 2304, ZN_GATE = 2560;

typedef unsigned short bf16;
typedef short bf16x8 __attribute__((ext_vector_type(8)));
typedef float f32x4 __attribute__((ext_vector_type(4)));
typedef float f32x16 __attribute__((ext_vector_type(16)));
typedef unsigned u32x4 __attribute__((ext_vector_type(4)));
typedef unsigned u32x2 __attribute__((ext_vector_type(2)));
typedef short s16x4 __attribute__((ext_vector_type(4)));
#define GAS __attribute__((address_space(1)))
#define LAS __attribute__((address_space(3)))
typedef GAS unsigned gu32;

__device__ __forceinline__ float bf2f(unsigned u) { return __uint_as_float(u << 16); }
__device__ __forceinline__ unsigned f2bf(float f) { unsigned u = __float_as_uint(f); return (u + 0x7fffu + ((u >> 16) & 1u)) >> 16; }
__device__ __forceinline__ unsigned pk2(float lo, float hi) { return f2bf(lo) | (f2bf(hi) << 16); }
__device__ __forceinline__ u32x4 pack8(const f32x4 a, const f32x4 b) { u32x4 w; w.x = pk2(a[0], a[1]); w.y = pk2(a[2], a[3]); w.z = pk2(b[0], b[1]); w.w = pk2(b[2], b[3]); return w; }
__device__ __forceinline__ float sigmoidf_(float x) { return __builtin_amdgcn_rcpf(1.0f + __expf(-x)); }
template <int CTRL> __device__ __forceinline__ float dppf(float x) { return __builtin_bit_cast(float, __builtin_amdgcn_update_dpp(0, __builtin_bit_cast(int, x), CTRL, 0xF, 0xF, true)); }
__device__ __forceinline__ float wave_sum(float v) {
    v += dppf<0xB1>(v); v += dppf<0x4E>(v); v += dppf<0x141>(v); v += dppf<0x140>(v);
    const int vi = __builtin_bit_cast(int, v);
    return (__builtin_bit_cast(float, __builtin_amdgcn_readlane(vi, 0)) + __builtin_bit_cast(float, __builtin_amdgcn_readlane(vi, 16))) +
           (__builtin_bit_cast(float, __builtin_amdgcn_readlane(vi, 32)) + __builtin_bit_cast(float, __builtin_amdgcn_readlane(vi, 48)));
}

constexpr size_t MiB = 1u << 20;
constexpr size_t WS_CTL = 0, CTL_ZERO_BYTES = 1 * MiB;
constexpr size_t CTL_ROWSQ1 = 256 * 1024, CTL_ROWSQ2 = 320 * 1024;
constexpr size_t WS_LORAT = 1 * MiB, WS_W1T = 3 * MiB, WS_WOUTT = 5 * MiB, WS_WOT = 13 * MiB, WS_MISC = 21 * MiB;
constexpr size_t WS_WINT = 22 * MiB, WS_XN = 62 * MiB;
constexpr size_t WS_LORA = 22 * MiB;
constexpr size_t WS_SALL = 22 * MiB;
constexpr size_t WS_MIXED = 22 * MiB;
constexpr size_t WS_H1B = 54 * MiB;
constexpr size_t WS_QC = 70 * MiB, WS_YH = 86 * MiB;
constexpr size_t WS_ZR = 102 * MiB, WS_ZN = 158 * MiB, WS_ZG = 202 * MiB;
constexpr size_t WS_UPT = 102 * MiB, WS_DOWNT = 134 * MiB;
constexpr size_t WS_ACT = 166 * MiB;
constexpr size_t WS_A2 = 266 * MiB, WS_AG = 278 * MiB, WS_HPART = 294 * MiB;
constexpr size_t WS_BON = 266 * MiB;
constexpr size_t WS_YAB = 282 * MiB;
constexpr size_t WS_KCV = 314 * MiB;
constexpr size_t WS_END = 315 * MiB;
constexpr int CW_TMO = 0, CW_BAR = 4096;

constexpr int RING_BYTES = 131072, LDSCTL_OFF = 139264, MISC_OFF = LDSCTL_OFF + 320, LDS_BYTES = 147456;

__device__ __forceinline__ void tile_decode(int wgid, int nwg, int nM, int nN, int& pm, int& pn) {
    const int q = nwg / 8, r = nwg % 8, xcd = wgid % 8, off = wgid / 8;
    wgid = (xcd < r ? xcd * (q + 1) : r * (q + 1) + (xcd - r) * q) + off;
    const int nig = 8 * nN, gid = wgid / nig, fm = gid * 8, gsz = (nM - fm) < 8 ? (nM - fm) : 8;
    pm = fm + ((wgid % nig) % gsz); pn = (wgid % nig) / gsz;
}
template <int nM, int nN, int nblk>
struct CatOrder {
    int G, c;
    __device__ void init(int G_, int c_) { G = G_; c = c_; }
    __device__ bool next(int i, pg8::Unit& u) const {
        constexpr int nbase = nM * nN;
        const int L = i * G + c; if (L >= nbase * nblk) return false;
        const int blk = L / nbase, w = L % nbase; int pm, pn; tile_decode(w, nbase, nM, nN, pm, pn);
        u.pm = pm + blk * nM; u.pn = pn + blk * nN; return true;
    }
    __device__ __forceinline__ void a_ready(const pg8::Unit&) const {}
    __device__ __forceinline__ void done(const pg8::Unit&) const {}
};
template <int nM, int nN>
struct PairOrder {
    int G, c;
    __device__ void init(int G_, int c_) { G = G_; c = c_; }
    __device__ bool next(int i, pg8::Unit& u) const {
        constexpr int nbase = nM * nN;
        const int L = (i >> 1) * G + c; if (L >= nbase) return false;
        int pm, pn; tile_decode(L, nbase, nM, nN, pm, pn);
        u.pm = pm + (i & 1) * nM; u.pn = pn + (i & 1) * nN; return true;
    }
    __device__ __forceinline__ void a_ready(const pg8::Unit&) const {}
    __device__ __forceinline__ void done(const pg8::Unit&) const {}
};

typedef const f32x4 (&AccC)[2][2][4][2];
typedef f32x4 (&AccM)[2][2][4][2];

struct EpiProj {
    static constexpr bool PERM = true, AFTER_DRAIN = false, CHAIN = false;
    bf16 *ZR, *ZN, *ZG;
    __device__ __forceinline__ void operator()(AccC acc, const pg8::Unit& u, int wr, int wc, int fr, int fq) const {
        const int row0 = u.pm * 256 + wr * 64 + fr;
#pragma unroll
        for (int bj = 0; bj < 2; ++bj) {
            const int c = u.pn * 256 + bj * 128 + wc * 32 + 8 * fq;
            bf16* p; int ld;
            if (c < 3520) { p = ZR + c; ld = ZR_LD; } else if (c < 6128) { p = ZN + (c - 3520); ld = ZN_LD; } else if (c < INC) { p = ZG + (c - 6128); ld = ZG_LD; } else continue;
#pragma unroll
            for (int ai = 0; ai < 2; ++ai)
#pragma unroll
                for (int m = 0; m < 4; ++m) { const int row = row0 + ai * 128 + m * 16; *(u32x4*)(p + (size_t)row * ld) = pack8(acc[ai][bj][m][0], acc[ai][bj][m][1]); }
        }
    }
};
struct EpiLora {
    static constexpr bool PERM = true, AFTER_DRAIN = false, CHAIN = false;
    bf16* LORA; const float* w0; const float* a0;
    template <int WHICH> __device__ __forceinline__ void run(AccC acc, const pg8::Unit& u, int wr, int wc, int fr, int fq) const {
        const int row0 = (u.pm - 32 * WHICH) * 256 + wr * 64 + fr;
        const float* bp = WHICH == 0 ? w0 : a0;
#pragma unroll
        for (int bj = 0; bj < 2; ++bj) {
            const int col = (u.pn & 3) * 256 + bj * 128 + wc * 32 + 8 * fq;
            f32x4 bias0 = (f32x4){0.f, 0.f, 0.f, 0.f}, bias1 = bias0;
            if (WHICH < 2) { bias0 = *(const f32x4*)(bp + col); bias1 = *(const f32x4*)(bp + col + 4); }
            bf16* p = LORA + ((size_t)WHICH * NTOK + row0) * 1024 + col;
#pragma unroll
            for (int ai = 0; ai < 2; ++ai)
#pragma unroll
                for (int m = 0; m < 4; ++m) {
                    f32x4 v0 = acc[ai][bj][m][0] + bias0, v1 = acc[ai][bj][m][1] + bias1;
                    if (WHICH < 2) {
#pragma unroll
                        for (int e = 0; e < 4; ++e) { v0[e] = sigmoidf_(v0[e]); v1[e] = sigmoidf_(v1[e]); }
                        if (WHICH == 0) { v0 = v0 * -0.6065306597f; v1 = v1 * -0.6065306597f; }
                    }
                    *(u32x4*)(p + (size_t)(ai * 128 + m * 16) * 1024) = pack8(v0, v1);
                }
        }
    }
    __device__ __forceinline__ void operator()(AccC acc, const pg8::Unit& u, int wr, int wc, int fr, int fq) const {
        const int which = u.pn >> 2;
#ifdef LORA_PROBE
        run<2>(acc, u, wr, wc, fr, fq);
#else
        if (which == 0) run<0>(acc, u, wr, wc, fr, fq); else if (which == 1) run<1>(acc, u, wr, wc, fr, fq); else run<2>(acc, u, wr, wc, fr, fq);
#endif
    }
};
struct EpiHpart {
    static constexpr bool PERM = false, AFTER_DRAIN = false, CHAIN = false;
    float* C;
    __device__ __forceinline__ void operator()(AccC acc, const pg8::Unit& u, int wr, int wc, int fr, int fq) const {
        const int row0 = u.pm * 256 + wr * 64 + fr, col0 = wc * 32 + 4 * fq;
#pragma unroll
        for (int ai = 0; ai < 2; ++ai)
#pragma unroll
            for (int m = 0; m < 4; ++m) { float* rowp = C + (size_t)(row0 + ai * 128 + m * 16) * 256 + col0;
#pragma unroll
                for (int bj = 0; bj < 2; ++bj)
#pragma unroll
                    for (int n = 0; n < 2; ++n) *(f32x4*)(rowp + bj * 128 + n * 16) = acc[ai][bj][m][n]; }
    }
};
struct EpiMerge {
    static constexpr bool PERM = true, AFTER_DRAIN = false, CHAIN = false;
    const bf16* ZG; bf16* MIXED;
    __device__ __forceinline__ void operator()(AccC acc, const pg8::Unit& u, int wr, int wc, int fr, int fq) const {
        const int second = u.pm >= 32 ? 1 : 0;
        const int row0 = (u.pm - 32 * second) * 256 + wr * 64 + fr, colb = (u.pn - 8 * second) * 256 + wc * 32 + 8 * fq;
#pragma unroll
        for (int ai = 0; ai < 2; ++ai)
#pragma unroll
            for (int m = 0; m < 4; ++m) {
                const size_t row = (size_t)(row0 + ai * 128 + m * 16);
#pragma unroll
                for (int bj = 0; bj < 2; ++bj) {
                    const u32x4 gt = *(const u32x4*)(ZG + row * ZG_LD + 2048 * second + colb + bj * 128);
                    u32x4 prev = (u32x4){0u, 0u, 0u, 0u};
                    if (second) prev = *(const u32x4*)(MIXED + row * DM + colb + bj * 128);
                    float v[8];
#pragma unroll
                    for (int e = 0; e < 8; ++e) {
                        const float gv = (e & 1) ? bf2f(gt[e >> 1] >> 16) : bf2f(gt[e >> 1] & 0xffffu), pv = (e & 1) ? bf2f(prev[e >> 1] >> 16) : bf2f(prev[e >> 1] & 0xffffu);
                        v[e] = pv + acc[ai][bj][m][e >> 2][e & 3] * sigmoidf_(gv);
                    }
                    u32x4 w; w.x = pk2(v[0], v[1]); w.y = pk2(v[2], v[3]); w.z = pk2(v[4], v[5]); w.w = pk2(v[6], v[7]);
                    *(u32x4*)(MIXED + row * DM + colb + bj * 128) = w;
                }
                asm volatile("" ::: "memory");
            }
    }
};
struct EpiWo {
    static constexpr bool PERM = false, AFTER_DRAIN = false, CHAIN = false;
    const float* X; float* H1; bf16* H1B; float* rowsq;
    __device__ __forceinline__ void operator()(AccC acc, const pg8::Unit& u, int wr, int wc, int fr, int fq) const {
        const int row0 = u.pm * 256 + wr * 64 + fr, col0 = u.pn * 256 + wc * 32 + 4 * fq;
#pragma unroll
        for (int ai = 0; ai < 2; ++ai)
#pragma unroll
            for (int m = 0; m < 4; ++m) {
                const int row = row0 + ai * 128 + m * 16; const size_t off = (size_t)row * DM + col0; float ss = 0.f;
#pragma unroll
                for (int bj = 0; bj < 2; ++bj)
#pragma unroll
                    for (int n = 0; n < 2; ++n) {
                        const f32x4 h = *(const f32x4*)(X + off + bj * 128 + n * 16) + acc[ai][bj][m][n];
                        *(f32x4*)(H1 + off + bj * 128 + n * 16) = h;
                        u32x2 w; w.x = pk2(h[0], h[1]); w.y = pk2(h[2], h[3]); *(u32x2*)(H1B + off + bj * 128 + n * 16) = w;
                        ss += (h[0] * h[0] + h[1] * h[1]) + (h[2] * h[2] + h[3] * h[3]);
                    }
                ss += __shfl_xor(ss, 16); ss += __shfl_xor(ss, 32);
                if (fq == 0) atomicAdd(rowsq + row, ss);
            }
    }
};
struct EpiUp {
    static constexpr bool PERM = true, AFTER_DRAIN = false, CHAIN = false;
    const float* rowsq; bf16* ACT;
    __device__ __forceinline__ void operator()(AccC acc, const pg8::Unit& u, int wr, int wc, int fr, int fq) const {
        const int row0 = u.pm * 256 + wr * 64 + fr;
#pragma unroll
        for (int ai = 0; ai < 2; ++ai)
#pragma unroll
            for (int m = 0; m < 4; ++m) {
                const int row = row0 + ai * 128 + m * 16;
                const float rs = rsqrtf(__hip_atomic_load(rowsq + row, __ATOMIC_RELAXED, __HIP_MEMORY_SCOPE_AGENT) * (1.0f / DM) + 1e-5f);
#pragma unroll
                for (int bj = 0; bj < 2; ++bj) {
                    const int col = u.pn * 256 + bj * 128 + wc * 32 + 8 * fq; float v[8];
#pragma unroll
                    for (int e = 0; e < 8; ++e) { const float x = fmaxf(acc[ai][bj][m][e >> 2][e & 3] * rs, 0.f); v[e] = x * x; }
                    u32x4 w; w.x = pk2(v[0], v[1]); w.y = pk2(v[2], v[3]); w.z = pk2(v[4], v[5]); w.w = pk2(v[6], v[7]);
                    *(u32x4*)(ACT + (size_t)row * DFF + col) = w;
                }
            }
    }
};
struct EpiDown {
    static constexpr bool PERM = false, AFTER_DRAIN = false, CHAIN = false;
    float* H; float* rowsq;
    __device__ __forceinline__ void operator()(AccC acc, const pg8::Unit& u, int wr, int wc, int fr, int fq) const {
        const int row0 = u.pm * 256 + wr * 64 + fr, col0 = u.pn * 256 + wc * 32 + 4 * fq;
#pragma unroll
        for (int ai = 0; ai < 2; ++ai)
#pragma unroll
            for (int m = 0; m < 4; ++m) {
                const int row = row0 + ai * 128 + m * 16; const size_t off = (size_t)row * DM + col0; float ss = 0.f;
#pragma unroll
                for (int bj = 0; bj < 2; ++bj)
#pragma unroll
                    for (int n = 0; n < 2; ++n) {
                        const f32x4 h = *(const f32x4*)(H + off + bj * 128 + n * 16) + acc[ai][bj][m][n];
                        *(f32x4*)(H + off + bj * 128 + n * 16) = h;
                        ss += (h[0] * h[0] + h[1] * h[1]) + (h[2] * h[2] + h[3] * h[3]);
                    }
                ss += __shfl_xor(ss, 16); ss += __shfl_xor(ss, 32);
                if (fq == 0) atomicAdd(rowsq + row, ss);
            }
    }
};
#define XB_TMO      128
#define XB_XCNT(j)  (256  + 64 * (j))
#define XB_XSUB(j)  (1280 + 64 * (j))
#define XB_XGEN(j)  (2304 + 64 * (j))
#define XB_TOP      3328
#define XB_TOPGEN   3392
#define XCD_BAR_WORDS 3456
#define XB_SPIN_CAP (1u << 18)

__device__ __forceinline__ unsigned xb_ld(unsigned* p)              { return __hip_atomic_load(p, __ATOMIC_RELAXED, __HIP_MEMORY_SCOPE_AGENT); }
__device__ __forceinline__ unsigned xb_add(unsigned* p, unsigned v) { return __hip_atomic_fetch_add(p, v, __ATOMIC_RELAXED, __HIP_MEMORY_SCOPE_AGENT); }
__device__ __forceinline__ unsigned xb_xcc_id() { return (unsigned)__builtin_amdgcn_s_getreg((3 << 11) | 20) & 0xFu; }
#define XB_SPIN(cond, bar) do { unsigned _sp = 0; while (cond) { __builtin_amdgcn_s_sleep(1); \
    if ((++_sp & 255u) == 0u) { if (xb_ld(&(bar)[XB_TMO])) break; if (_sp > XB_SPIN_CAP) { atomicAdd(&(bar)[XB_TMO], 1u); break; } } } } while (0)

struct XcdBarrier {
    unsigned* bar; unsigned x;
    volatile LAS unsigned* st;
};

__device__ __forceinline__ XcdBarrier xcd_barrier_post(unsigned* bar, volatile LAS unsigned* st, int tid_) {
    XcdBarrier b; b.bar = bar; b.x = xb_xcc_id(); b.st = st;
    if (tid_ == 0) (void)xb_add(&bar[XB_XCNT(b.x)], 1u);
    return b;
}
__device__ __forceinline__ void xcd_barrier_complete(unsigned* bar, unsigned x, unsigned& nloc, unsigned& nx) {
    const unsigned G = gridDim.x * gridDim.y * gridDim.z;
    unsigned sum, cnt, mine, sp = 0u;
    for (;;) {
        sum = 0u; cnt = 0u; mine = 0u;
#pragma unroll
        for (unsigned j = 0; j < 16; ++j) { const unsigned c = xb_ld(&bar[XB_XCNT(j)]); sum += c; cnt += (c > 0u) ? 1u : 0u; mine = (j == x) ? c : mine; }
        if (sum == G) break;
        __builtin_amdgcn_s_sleep(1);
        if ((++sp & 255u) == 0u) { if (xb_ld(&bar[XB_TMO])) break; if (sp > XB_SPIN_CAP) { atomicAdd(&bar[XB_TMO], 1u); break; } }
    }
    nloc = mine > 0u ? mine : 1u; nx = cnt > 0u ? cnt : 1u;
}

__device__ __forceinline__ void xcd_barrier(const XcdBarrier& b, int tid_) {
    asm volatile("s_waitcnt vmcnt(0)" ::: "memory");
    __syncthreads();
    if (tid_ == 0) {
        unsigned* bar = b.bar;
        __builtin_amdgcn_s_waitcnt(0);
        unsigned nloc = b.st[0], nx = b.st[1];
        if (nloc == 0u) { xcd_barrier_complete(bar, b.x, nloc, nx); b.st[0] = nloc; b.st[1] = nx; }
        const unsigned old = xb_add(&bar[XB_XSUB(b.x)], 1u);
        const unsigned gen = old / nloc;
        if (old + 1u == (gen + 1u) * nloc) {
            __builtin_amdgcn_fence(__ATOMIC_RELEASE, "agent");
            asm volatile("s_waitcnt vmcnt(0)" ::: "memory");
            const unsigned og = xb_add(&bar[XB_TOP], 1u);
            const unsigned tg = og / nx;
            if (og + 1u == (tg + 1u) * nx) xb_add(&bar[XB_TOPGEN], 1u);
            else XB_SPIN(xb_ld(&bar[XB_TOPGEN]) == tg, bar);
            __builtin_amdgcn_fence(__ATOMIC_ACQUIRE, "agent");
            xb_add(&bar[XB_XGEN(b.x)], 1u);
            asm volatile("s_waitcnt vmcnt(0)" ::: "memory");
        } else {
            XB_SPIN(xb_ld(&bar[XB_XGEN(b.x)]) == gen, bar);
            __builtin_amdgcn_fence(__ATOMIC_ACQUIRE, "agent");
            asm volatile("s_waitcnt vmcnt(0)" ::: "memory");
        }
    }
    __syncthreads();
}

struct Args { const float* in[27]; float* out; unsigned char* ws; int ph_lo, ph_hi, li, pad; };
struct Frame {
    LAS unsigned char* lds;
    int tid, lane, wave, vcu, G;
    const float* const* in;
};
#define LDS_WAIT() asm volatile("s_waitcnt lgkmcnt(0)" ::: "memory")

__device__ __forceinline__ void cvt_item(const float* W, int ldw, int Kv, int Nv, int k0, int n0, bf16* dst, int ldd, const float* ksc, LAS unsigned* scr, int lane) {
    const int q = lane >> 4, nq = lane & 15, n = n0 + 4 * nq;
    f32x4 v[16];
#pragma unroll
    for (int i = 0; i < 16; ++i) {
        const int k = k0 + (i & 1) + 2 * q + 8 * (i >> 1);
        v[i] = (f32x4){0.f, 0.f, 0.f, 0.f};
        if (k < Kv && n < Nv) { v[i] = *(const f32x4*)(W + (size_t)k * ldw + n); if (ksc) v[i] = v[i] * ksc[k]; }
    }
#pragma unroll
    for (int ip = 0; ip < 8; ++ip)
#pragma unroll
        for (int e = 0; e < 4; ++e) { const int nn = 4 * nq + e; scr[nn * 32 + 4 * (ip ^ (nq & 7)) + q] = pk2(v[2 * ip][e], v[2 * ip + 1][e]); }
    LDS_WAIT(); asm volatile("" ::: "memory");
    const int c = lane & 7;
#pragma unroll
    for (int j = 0; j < 8; ++j) {
        const int nn = (lane >> 3) + 8 * j;
        const u32x4 o = *(const LAS u32x4*)(scr + nn * 32 + 4 * (c ^ ((nn >> 2) & 7)));
        *(u32x4*)(dst + (size_t)(n0 + nn) * ldd + k0 + 8 * c) = o;
    }
    LDS_WAIT(); asm volatile("" ::: "memory");
}
#define CVT_MAT(W_, ldw_, Kv_, Nv_, nkb_, nnb_, dst_, ldd_, ksc_) { const int cnt_ = (nkb_) * (nnb_); if (r < cnt_) { cvt_item(W_, ldw_, Kv_, Nv_, 64 * (r / (nnb_)), 64 * (r % (nnb_)), dst_, ldd_, ksc_, scr, F.lane); continue; } r -= cnt_; }

__device__ __forceinline__ void ph0_prologue(const Frame& F, const Args& A) {
    unsigned char* ws = A.ws;
    LAS unsigned* scr = (LAS unsigned*)(F.lds + F.wave * 8192);
    const int gw = F.vcu * 8 + F.wave, NGW = F.G * 8;
    bf16* WinT = (bf16*)(ws + WS_WINT); bf16* LoraT = (bf16*)(ws + WS_LORAT); bf16* W1T = (bf16*)(ws + WS_W1T); bf16* WoutT = (bf16*)(ws + WS_WOUTT); bf16* WoT = (bf16*)(ws + WS_WOT);
    if (gw < 64) {
        const int which = gw >> 5, kseg = (gw >> 2) & 7, c = (gw & 3) * 64 + F.lane;
        const float* pe = (which ? A.in[17] : A.in[14]) + kseg * 256; const float* w1 = (which ? A.in[18] : A.in[15]) + (size_t)kseg * 256 * 256 + c;
        float s0 = 0.f, s1 = 0.f, s2 = 0.f, s3 = 0.f;
#pragma unroll 4
        for (int k = 0; k < 256; k += 4) { s0 += pe[k] * w1[(size_t)k * 256]; s1 += pe[k + 1] * w1[(size_t)(k + 1) * 256]; s2 += pe[k + 2] * w1[(size_t)(k + 2) * 256]; s3 += pe[k + 3] * w1[(size_t)(k + 3) * 256]; }
        ((float*)(ws + WS_MISC))[(kseg * 2 + which) * 256 + c] = (s0 + s1) + (s2 + s3);
    }
    constexpr int N_WIN = 32 * 160, N_LORA = 4 * 16, N_W1 = 8 * 4, N_WOUT = 16 * 32, N_WO = 32 * 32;
    constexpr int NITEMS = N_WIN + 3 * N_LORA + 8 * N_W1 + 2 * N_WOUT + N_WO;
    for (int it = gw; it < NITEMS; it += NGW) {
        int r = it;
        CVT_MAT(A.in[2], INC, 2048, INC, 32, 160, WinT, 2048, nullptr)
        CVT_MAT(A.in[5], 1024, 96, 1024, 4, 16, LoraT, 256, nullptr)
        CVT_MAT(A.in[7], 1024, 96, 1024, 4, 16, LoraT + 1024 * 256, 256, nullptr)
        CVT_MAT(A.in[8], 1024, 256, 1024, 4, 16, LoraT + 2 * 1024 * 256, 256, nullptr)
#pragma unroll
        for (int ks = 0; ks < 4; ++ks) {
            CVT_MAT(A.in[15] + (size_t)ks * 512 * 256, 256, 512, 256, 8, 4, W1T + (size_t)((ks * 2 + 0) * 256) * 512, 512, nullptr)
            CVT_MAT(A.in[18] + (size_t)ks * 512 * 256, 256, 512, 256, 8, 4, W1T + (size_t)((ks * 2 + 1) * 256) * 512, 512, nullptr)
        }
        CVT_MAT(A.in[20], 2048, 1024, 2048, 16, 32, WoutT, 1024, nullptr)
        CVT_MAT(A.in[21], 2048, 1024, 2048, 16, 32, WoutT + (size_t)2048 * 1024, 1024, nullptr)
        CVT_MAT(A.in[22], 2048, 2048, 2048, 32, 32, WoT, 2048, nullptr)
    }
    {
        const float* x = A.in[0]; const float* nm = A.in[1]; bf16* XN = (bf16*)(ws + WS_XN);
        for (int m = gw; m < NTOK; m += NGW) {
            const f32x4* xr = (const f32x4*)(x + (size_t)m * DM) + F.lane; f32x4 v[8]; float s = 0.f;
#pragma unroll
            for (int j = 0; j < 8; ++j) { v[j] = xr[64 * j]; s += (v[j][0] * v[j][0] + v[j][1] * v[j][1]) + (v[j][2] * v[j][2] + v[j][3] * v[j][3]); }
            const float rstd = rsqrtf(wave_sum(s) * (1.f / DM) + 1e-5f);
#pragma unroll
            for (int j = 0; j < 8; ++j) {
                const f32x4 g = *((const f32x4*)nm + F.lane + 64 * j); u32x2 w;
                w.x = pk2(v[j][0] * rstd * g[0], v[j][1] * rstd * g[1]); w.y = pk2(v[j][2] * rstd * g[2], v[j][3] * rstd * g[3]);
                *((u32x2*)(XN + (size_t)m * DM) + F.lane + 64 * j) = w;
            }
        }
    }
}
__device__ __forceinline__ void ph_cvt_mlp(const Frame& F, const Args& A) {
    unsigned char* ws = A.ws;
    LAS unsigned* scr = (LAS unsigned*)(F.lds + F.wave * 8192);
    const int gw = F.vcu * 8 + F.wave, NGW = F.G * 8;
    bf16* UpT = (bf16*)(ws + WS_UPT); bf16* DownT = (bf16*)(ws + WS_DOWNT);
    constexpr int NITEMS = 32 * 128 + 128 * 32;
    for (int it = gw; it < NITEMS; it += NGW) {
        int r = it;
        CVT_MAT(A.in[24], DFF, 2048, DFF, 32, 128, UpT, 2048, A.in[23])
        CVT_MAT(A.in[25], 2048, DFF, 2048, 128, 32, DownT, DFF, nullptr)
    }
}

__device__ __forceinline__ void ph2_build(const Frame& F, const Args& A) {
    unsigned char* ws = A.ws;
    const bf16* ZR = (const bf16*)(ws + WS_ZR); const bf16* ZN = (const bf16*)(ws + WS_ZN);
    bf16* A2 = (bf16*)(ws + WS_A2); bf16* Ag = (bf16*)(ws + WS_AG);
    const float* mu = A.in[3];
    const int gt = F.vcu * 512 + F.tid, NGT = F.G * 512;
    for (int idx = gt; idx < 3 * NTOK * 32; idx += NGT) {
        const int blk = idx / (NTOK * 32), row = (idx >> 5) & (NTOK - 1), c0 = (idx & 31) * 8;
        u32x4 o = (u32x4){0u, 0u, 0u, 0u};
        if (blk == 2 || c0 < 96) {
            const int col = (blk == 0 ? 3072 : (blk == 1 ? 3168 : 3264)) + c0;
            const u32x4 z = *(const u32x4*)(ZR + (size_t)row * ZR_LD + col);
            u32x4 zp = (u32x4){0u, 0u, 0u, 0u};
            if ((row & (SEQ - 1)) != 0) zp = *(const u32x4*)(ZR + (size_t)(row - 1) * ZR_LD + col);
            float v[8];
#pragma unroll
            for (int e = 0; e < 8; ++e) {
                const float a = (e & 1) ? bf2f(z[e >> 1] >> 16) : bf2f(z[e >> 1] & 0xffffu), p = (e & 1) ? bf2f(zp[e >> 1] >> 16) : bf2f(zp[e >> 1] & 0xffffu);
                const float s = a + (p - a) * mu[col + e];
                v[e] = blk == 0 ? tanhf(s) : (blk == 1 ? s : sigmoidf_(s));
            }
            o.x = pk2(v[0], v[1]); o.y = pk2(v[2], v[3]); o.z = pk2(v[4], v[5]); o.w = pk2(v[6], v[7]);
        }
        *(u32x4*)(A2 + (size_t)idx * 8) = o;
    }
    for (int idx = gt; idx < 8 * 2048 * 64; idx += NGT) {
        const int blk = idx >> 17, r = (idx >> 6) & 2047, cg = idx & 63, ks = blk >> 1, which = blk & 1;
        u32x4 o = (u32x4){0u, 0u, 0u, 0u};
        if (r < 2032) {
            const int kf = ks * 512 + cg * 8, l = kf >> 6, dd = kf & 63, b = r / 508, rem = r - b * 508, n = rem >> 2, g = rem & 3;
            o = *(const u32x4*)(ZN + (size_t)(b * SEQ + 16 * n + l) * ZN_LD + (which ? ZN_VC : ZN_KC) + g * 64 + dd);
        }
        *(u32x4*)(Ag + (size_t)idx * 8) = o;
    }
}

__device__ __forceinline__ void cmp_finish_unit(const Frame& F, const Args& A, int u) {
    unsigned char* ws = A.ws;
    const float* Hp = (const float*)(ws + WS_HPART); const float* bias1 = (const float*)(ws + WS_MISC);
    bf16* KCV = (bf16*)(ws + WS_KCV);
    const int which = u >> 6, rb = u & 63;
    const float* w2 = which ? A.in[19] : A.in[16];
    LAS float* h = (LAS float*)F.lds;
    __syncthreads();
    for (int idx = F.tid; idx < 32 * 256; idx += 512) {
        const int r = idx >> 8, c = idx & 255; float v = 0.f;
#pragma unroll
        for (int kseg = 0; kseg < 8; ++kseg) v += bias1[(kseg * 2 + which) * 256 + c];
#pragma unroll
        for (int ks = 0; ks < 4; ++ks) v += Hp[((size_t)((ks * 2 + which) * 2048) + 32 * rb + r) * 256 + c];
        const float t = 0.7978845608028654f * (v + 0.044715f * v * v * v);
        h[r * 257 + c] = 0.5f * v * (1.f + tanhf(t));
    }
    __syncthreads();
    const int r = F.tid >> 4, dq = F.tid & 15;
    f32x4 acc = (f32x4){0.f, 0.f, 0.f, 0.f};
#pragma unroll 16
    for (int c = 0; c < 256; ++c) { const float hv = h[r * 257 + c]; const f32x4 w = *(const f32x4*)(w2 + c * 64 + 4 * dq); acc += hv * w; }
    const int R = 32 * rb + r;
    if (R < 2032) {
        const int b = R / 508, rem = R - b * 508, n = rem >> 2, g = rem & 3;
        u32x2 w; w.x = pk2(acc[0], acc[1]); w.y = pk2(acc[2], acc[3]);
        *(u32x2*)(KCV + (size_t)which * (16 * 128 * 64) + ((size_t)(b * 4 + g) * 128 + n) * 64 + 4 * dq) = w;
    }
    if (u == 0 && F.tid < 512) {
        for (int i = F.tid; i < 2 * 16 * 32; i += 512) { const int wh = i / 512, bg = (i >> 5) & 15, c2 = i & 31; *(unsigned*)(KCV + (size_t)wh * (16 * 128 * 64) + ((size_t)bg * 128 + 127) * 64 + 2 * c2) = 0u; }
    }
}

typedef float f32x2 __attribute__((ext_vector_type(2)));
__device__ __forceinline__ float quad_sum(float x) {
    x += __builtin_bit_cast(float, __builtin_amdgcn_update_dpp(0, __builtin_bit_cast(int, x), 0xB1, 0xF, 0xF, true));
    x += __builtin_bit_cast(float, __builtin_amdgcn_update_dpp(0, __builtin_bit_cast(int, x), 0x4E, 0xF, 0xF, true));
    return x;
}
#ifdef TPROBE_LO
#define SCAN_TB() const unsigned long long tsc_ = __builtin_amdgcn_s_memrealtime()
#define SCAN_TE(x) (x) += __builtin_amdgcn_s_memrealtime() - tsc_
#else
#define SCAN_TB() do { } while (0)
#define SCAN_TE(x) do { } while (0)
#endif
__device__ __forceinline__ void scan_chunk(const Frame& F, const Args& A, int ch, LAS float* wl, unsigned long long& tprep, unsigned long long& tstep) {
    unsigned char* ws = A.ws;
    const bf16* ZR = (const bf16*)(ws + WS_ZR); const bf16* LD = (const bf16*)(ws + WS_LORA); const bf16* AA = LD + (size_t)NTOK * 1024;
    bf16* BON = (bf16*)(ws + WS_BON); bf16* QC = (bf16*)(ws + WS_QC); bf16* YH = (bf16*)(ws + WS_YH);
    float* AC = A.out; float* GC = A.out + (size_t)2048 * 4096;
    int lane_o = F.lane; asm volatile("" : "+v"(lane_o));
    const int lane = lane_o, cq = lane & 3, rg = lane >> 2;
    const int bh = ch >> 5, c = ch & 31, b = bh >> 4, h = bh & 15, hj = h * 64 + lane;
    const float* mu = A.in[3];
    const float mu_r = mu[hj], mu_k = mu[1024 + hj], mu_v = mu[2048 + hj];
    const float kkw = A.in[9][hj], kaw = A.in[10][hj], rkw = A.in[11][hj];
    f32x2 SA[4][8], SG[4][8];
#pragma unroll
    for (int r = 0; r < 4; ++r)
#pragma unroll
        for (int q = 0; q < 8; ++q) { const int col = 16 * cq + 2 * q, row = 4 * rg + r; SA[r][q] = (f32x2){row == col ? 1.f : 0.f, row == col + 1 ? 1.f : 0.f}; SG[r][q] = (f32x2){0.f, 0.f}; }
    const size_t row0 = (size_t)b * SEQ + c * 64;
    float pr = 0.f, pk = 0.f, pv = 0.f;
    if (c != 0) { const bf16* zp = ZR + (row0 - 1) * ZR_LD + hj; pr = bf2f(zp[0]); pk = bf2f(zp[1024]); pv = bf2f(zp[2048]); }
    LAS unsigned short* raw = (LAS unsigned short*)(wl + 8 * 384);
    const size_t lrow_ = row0 + 4 * (lane >> 5); const int lch_ = h * 64 + 2 * (lane & 31);
#define SCAN_LOAD(g_) do { const bf16* zb_ = ZR + (lrow_ + (g_) * 8) * ZR_LD + lch_; const bf16* lb_ = LD + (lrow_ + (g_) * 8) * 1024 + lch_; \
        _Pragma("unroll") for (int s_ = 0; s_ < 4; ++s_) { \
            _Pragma("unroll") for (int w_ = 0; w_ < 3; ++w_) __builtin_amdgcn_global_load_lds((const unsigned*)(zb_ + (size_t)s_ * ZR_LD + w_ * 1024), (LAS unsigned*)(raw + (2 * (5 * s_ + w_)) * 64), 4, 0, 0); \
            _Pragma("unroll") for (int w_ = 0; w_ < 2; ++w_) __builtin_amdgcn_global_load_lds((const unsigned*)(lb_ + (size_t)s_ * 1024 + (size_t)w_ * NTOK * 1024), (LAS unsigned*)(raw + (2 * (5 * s_ + 3 + w_)) * 64), 4, 0, 0); \
            asm volatile("" ::: "memory"); } } while (0)
#define SCAN_RAW(s_, w_) bf2f(raw[(2 * (5 * ((s_) & 3) + (w_)) + ((s_) >> 2)) * 64 + lane])
    SCAN_LOAD(0);
    for (int sg = 0; sg < 8; ++sg) {
        { SCAN_TB();
        asm volatile("s_waitcnt vmcnt(0)" ::: "memory");
#pragma unroll
        for (int s = 0; s < 8; ++s) {
            const size_t row = row0 + sg * 8 + s;
            const float zr = SCAN_RAW(s, 0), zk = SCAN_RAW(s, 1), zv = SCAN_RAW(s, 2);
            const float r = zr + (pr - zr) * mu_r, k = zk + (pk - zk) * mu_k, v = zv + (pv - zv) * mu_v;
            pr = zr; pk = zk; pv = zv;
            const float w = __expf(SCAN_RAW(s, 3)), a = SCAN_RAW(s, 4);
            const float kkr = k * kkw; const float n2 = wave_sum(kkr * kkr); const float kk = kkr * rsqrtf(fmaxf(n2, 1e-24f));
            const float kp = k * (1.f + (a - 1.f) * kaw), bb = kk * a; const float rkr = wave_sum(r * kp * rkw);
            LAS float* o = wl + s * 384 + lane;
            o[0] = -kk; o[64] = w; o[128] = bb; o[192] = kp; o[256] = r; o[320] = v;
            BON[row * 1024 + hj] = (bf16)f2bf(rkr * v);
        }
        asm volatile("s_waitcnt lgkmcnt(0)" ::: "memory");
        if (sg < 7) SCAN_LOAD(sg + 1);
        SCAN_TE(tprep); }
        SCAN_TB();
        for (int s = 0; s < 8; ++s) {
            const LAS f32x4* p = (const LAS f32x4*)(wl + s * 384) + 4 * cq;
            const f32x4 v4 = *((const LAS f32x4*)(wl + s * 384 + 320) + rg);
            float sA[4], sG[4];
            {
                f32x2 nk[8];
#pragma unroll
                for (int q = 0; q < 4; ++q) { const f32x4 t = p[q]; nk[2 * q] = (f32x2){t[0], t[1]}; nk[2 * q + 1] = (f32x2){t[2], t[3]}; }
#pragma unroll
                for (int r = 0; r < 4; ++r) {
                    f32x2 aa = SA[r][0] * nk[0], gg = SG[r][0] * nk[0];
#pragma unroll
                    for (int q = 1; q < 8; ++q) { aa += SA[r][q] * nk[q]; gg += SG[r][q] * nk[q]; }
                    sA[r] = quad_sum(aa[0] + aa[1]); sG[r] = quad_sum(gg[0] + gg[1]);
                }
            }
            f32x2 w2[8], b2[8], k2[8], r2[8];
#pragma unroll
            for (int q = 0; q < 4; ++q) {
                const f32x4 tw = p[16 + q], tb = p[32 + q], tk = p[48 + q], tr = p[64 + q];
                w2[2 * q] = (f32x2){tw[0], tw[1]}; w2[2 * q + 1] = (f32x2){tw[2], tw[3]}; b2[2 * q] = (f32x2){tb[0], tb[1]}; b2[2 * q + 1] = (f32x2){tb[2], tb[3]};
                k2[2 * q] = (f32x2){tk[0], tk[1]}; k2[2 * q + 1] = (f32x2){tk[2], tk[3]}; r2[2 * q] = (f32x2){tr[0], tr[1]}; r2[2 * q + 1] = (f32x2){tr[2], tr[3]};
            }
            float yA[4], yG[4];
#pragma unroll
            for (int r = 0; r < 4; ++r) {
                const f32x2 sa2 = (f32x2){sA[r], sA[r]}, sg2 = (f32x2){sG[r], sG[r]}, vv2 = (f32x2){v4[r], v4[r]};
                f32x2 ya = (f32x2){0.f, 0.f}, yg = (f32x2){0.f, 0.f};
#pragma unroll
                for (int q = 0; q < 8; ++q) {
                    SA[r][q] = SA[r][q] * w2[q] + sa2 * b2[q];
                    SG[r][q] = SG[r][q] * w2[q] + sg2 * b2[q] + vv2 * k2[q];
                    ya += SA[r][q] * r2[q]; yg += SG[r][q] * r2[q];
                }
                yA[r] = quad_sum(ya[0] + ya[1]); yG[r] = quad_sum(yg[0] + yg[1]);
            }
            if (cq == 0) {
                const size_t oidx = (size_t)ch * 4096 + (sg * 8 + s) * 64 + 4 * rg;
                u32x2 wq; wq.x = pk2(yA[0], yA[1]); wq.y = pk2(yA[2], yA[3]); *(u32x2*)(QC + oidx) = wq;
                u32x2 wy; wy.x = pk2(yG[0], yG[1]); wy.y = pk2(yG[2], yG[3]); *(u32x2*)(YH + oidx) = wy;
            }
        }
        SCAN_TE(tstep);
    }
#pragma unroll
    for (int r = 0; r < 4; ++r) {
        float* ap = AC + (size_t)ch * 4096 + (4 * rg + r) * 64 + 16 * cq; float* gp = GC + (size_t)ch * 4096 + (4 * rg + r) * 64 + 16 * cq;
#pragma unroll
        for (int q = 0; q < 4; ++q) {
            *(f32x4*)(ap + 4 * q) = (f32x4){SA[r][2 * q][0], SA[r][2 * q][1], SA[r][2 * q + 1][0], SA[r][2 * q + 1][1]};
            *(f32x4*)(gp + 4 * q) = (f32x4){SG[r][2 * q][0], SG[r][2 * q][1], SG[r][2 * q + 1][0], SG[r][2 * q + 1][1]};
        }
    }
}

__device__ __forceinline__ void r3_unit(const Frame& F, const Args& A, int bh, int rg) {
    unsigned char* ws = A.ws;
    const float* AC = A.out; const float* GC = A.out + (size_t)2048 * 4096; float* SALL = (float*)(ws + WS_SALL);
    LAS float* Sl = (LAS float*)F.lds;
    const int lane = F.lane, lr = lane & 15, lq = lane >> 4, ct = F.wave;
    __syncthreads();
    for (int i = F.tid; i < 2 * 16 * 66; i += 512) Sl[i] = 0.f;
    __syncthreads();
    if (ct < 4) {
        float Bf[16], Bn[16]; f32x4 acc, gn;
#define R3_LOAD(c_, B_, G_) do { const float* Ap_ = AC + (size_t)(bh * 32 + (c_)) * 4096; const float* Gp_ = GC + (size_t)(bh * 32 + (c_)) * 4096; \
        _Pragma("unroll") for (int kk = 0; kk < 16; ++kk) B_[kk] = Ap_[(4 * kk + lq) * 64 + 16 * ct + lr]; \
        _Pragma("unroll") for (int r_ = 0; r_ < 4; ++r_) G_[r_] = Gp_[(16 * rg + 4 * lq + r_) * 64 + 16 * ct + lr]; } while (0)
        R3_LOAD(0, Bf, acc);
        int cur = 0;
        for (int c = 0; c < 31; ++c) {
            if (c < 30) R3_LOAD(c + 1, Bn, gn);
            const LAS float* Sc = Sl + cur * (16 * 66);
#pragma unroll
            for (int kk = 0; kk < 16; ++kk) acc = __builtin_amdgcn_mfma_f32_16x16x4f32(Sc[lr * 66 + 4 * kk + lq], Bf[kk], acc, 0, 0, 0);
            LAS float* Sn = Sl + (cur ^ 1) * (16 * 66);
            float* So = SALL + (size_t)(bh * 32 + c + 1) * 4096;
#pragma unroll
            for (int r_ = 0; r_ < 4; ++r_) { Sn[(4 * lq + r_) * 66 + 16 * ct + lr] = acc[r_]; So[(16 * rg + 4 * lq + r_) * 64 + 16 * ct + lr] = acc[r_]; }
            __syncthreads();
            cur ^= 1;
#pragma unroll
            for (int kk = 0; kk < 16; ++kk) Bf[kk] = Bn[kk];
            acc = gn;
        }
#undef R3_LOAD
    } else {
        for (int c = 0; c < 31; ++c) __syncthreads();
    }
}

__device__ __forceinline__ void r4_all(const Frame& F, const Args& A) {
    unsigned char* ws = A.ws;
    const bf16* QC = (const bf16*)(ws + WS_QC); const bf16* YH = (const bf16*)(ws + WS_YH); const float* SALL = (const float*)(ws + WS_SALL);
    const bf16* BON = (const bf16*)(ws + WS_BON); const bf16* GG = (const bf16*)(ws + WS_LORA) + (size_t)2 * NTOK * 1024; bf16* YA = (bf16*)(ws + WS_YAB);
    const float* lnw = A.in[12]; const float* lnb = A.in[13];
    const int lane = F.lane, lr = lane & 15, lq = lane >> 4, half = F.wave >> 2, st = F.wave & 3, t2 = F.tid & 255;
    LAS float* Qf = (LAS float*)F.lds + half * (2 * 64 * 66); LAS float* Sf = Qf + 64 * 66;
    u32x4 q0, q1; f32x4 s0, s1, s2, s3;
#define R4_LOAD(cp_) do { const int ch_ = 2 * (cp_) + half; const u32x4* qp_ = (const u32x4*)(QC + (size_t)ch_ * 4096); const f32x4* sp_ = (const f32x4*)(SALL + (size_t)ch_ * 4096); \
        q0 = qp_[t2]; q1 = qp_[t2 + 256]; \
        if ((ch_ & 31) != 0) { s0 = sp_[t2]; s1 = sp_[t2 + 256]; s2 = sp_[t2 + 512]; s3 = sp_[t2 + 768]; } else { s0 = (f32x4){0.f, 0.f, 0.f, 0.f}; s1 = s0; s2 = s0; s3 = s0; } } while (0)
#define R4_WQ(q_, p_) do { const int e_ = 8 * (p_), s_ = e_ >> 6, k_ = e_ & 63; LAS f32x2* d_ = (LAS f32x2*)(Qf + s_ * 66 + k_); \
        d_[0] = (f32x2){bf2f(q_[0] & 0xffffu), bf2f(q_[0] >> 16)}; d_[1] = (f32x2){bf2f(q_[1] & 0xffffu), bf2f(q_[1] >> 16)}; \
        d_[2] = (f32x2){bf2f(q_[2] & 0xffffu), bf2f(q_[2] >> 16)}; d_[3] = (f32x2){bf2f(q_[3] & 0xffffu), bf2f(q_[3] >> 16)}; } while (0)
#define R4_WS(v_, p_) do { const int e_ = 4 * (p_), i_ = e_ >> 6, k_ = e_ & 63; LAS f32x2* d_ = (LAS f32x2*)(Sf + i_ * 66 + k_); d_[0] = (f32x2){v_[0], v_[1]}; d_[1] = (f32x2){v_[2], v_[3]}; } while (0)
    int cp = F.vcu;
    if (cp < 1024) R4_LOAD(cp);
    for (; cp < 1024; cp += F.G) {
        const int ch = 2 * cp + half, c = ch & 31, bh = ch >> 5, b = bh >> 4, h = bh & 15;
        __syncthreads();
        R4_WQ(q0, t2); R4_WQ(q1, t2 + 256); R4_WS(s0, t2); R4_WS(s1, t2 + 256); R4_WS(s2, t2 + 512); R4_WS(s3, t2 + 768);
        if (cp + F.G < 1024) R4_LOAD(cp + F.G);
        f32x4 acc[4]; float bon[4][4], gg[4][4];
#pragma unroll
        for (int it = 0; it < 4; ++it)
#pragma unroll
            for (int rg_ = 0; rg_ < 4; ++rg_) {
                const size_t row = (size_t)b * SEQ + c * 64 + 16 * st + 4 * lq + rg_; const int col = h * 64 + 16 * it + lr;
                acc[it][rg_] = bf2f(YH[(size_t)ch * 4096 + (16 * st + 4 * lq + rg_) * 64 + 16 * it + lr]);
                bon[it][rg_] = bf2f(BON[row * 1024 + col]); gg[it][rg_] = bf2f(GG[row * 1024 + col]);
            }
        __syncthreads();
#pragma unroll
        for (int kk = 0; kk < 16; ++kk) {
            const float a = Qf[(16 * st + lr) * 66 + 4 * kk + lq];
#pragma unroll
            for (int it = 0; it < 4; ++it) acc[it] = __builtin_amdgcn_mfma_f32_16x16x4f32(a, Sf[(16 * it + lr) * 66 + 4 * kk + lq], acc[it], 0, 0, 0);
        }
#pragma unroll
        for (int rg_ = 0; rg_ < 4; ++rg_) {
            float s = (acc[0][rg_] + acc[1][rg_]) + (acc[2][rg_] + acc[3][rg_]);
            s += dppf<0xB1>(s); s += dppf<0x4E>(s); s += dppf<0x141>(s); s += dppf<0x140>(s);
            const float mean = s * (1.f / 64.f);
            float d[4], q = 0.f;
#pragma unroll
            for (int it = 0; it < 4; ++it) { d[it] = acc[it][rg_] - mean; q += d[it] * d[it]; }
            q += dppf<0xB1>(q); q += dppf<0x4E>(q); q += dppf<0x141>(q); q += dppf<0x140>(q);
            const float rstd = rsqrtf(q * (1.f / 64.f) + 64e-5f);
            const size_t row = (size_t)b * SEQ + c * 64 + 16 * st + 4 * lq + rg_;
#pragma unroll
            for (int it = 0; it < 4; ++it) {
                const int col = h * 64 + 16 * it + lr;
                const float y = (d[it] * rstd * lnw[col] + lnb[col] + bon[it][rg_]) * gg[it][rg_];
                YA[row * 1024 + col] = (bf16)f2bf(y);
            }
        }
    }
#undef R4_LOAD
#undef R4_WQ
#undef R4_WS
}

__device__ __forceinline__ int crow(int r, int hi) { return (r & 3) + 8 * (r >> 2) + 4 * hi; }
constexpr int NSA_KS = 0, NSA_VS = 8192, NSA_WSF = 16384, NSA_IMP = 17408, NSA_MASK = 17408 + 64 * 33 * 4, NSA_ANY = NSA_MASK + 256, NSA_QF = 32768, NSA_OST = 65536;

__device__ __forceinline__ u32x4 nsa_ldk(const bf16* Kg, int ld, int key0, int tid) { return *(const u32x4*)(Kg + (size_t)(key0 + (tid & 63)) * ld + (tid >> 6) * 8); }
__device__ __forceinline__ u32x4 nsa_ldv(const bf16* Vg, int ld, int key0, int tid) { const int w8 = tid >> 6, lane = tid & 63; return *(const u32x4*)(Vg + (size_t)(key0 + 16 * (w8 & 3) + (lane >> 2)) * ld + (w8 >> 2) * 32 + (lane & 3) * 8); }
__device__ __forceinline__ s16x4 nsa_vtr(const LAS unsigned char* p) { typedef short v4i16_t __attribute__((ext_vector_type(4))); return __builtin_bit_cast(s16x4, __builtin_amdgcn_ds_read_tr16_b64_v4i16((LAS v4i16_t*)p)); }

__device__ __forceinline__ void nsa_qk(f32x16& p0, f32x16& p1, const LAS unsigned char* ks, const LAS unsigned char* qf, int r32, int hi) {
    const LAS unsigned char* kb = ks + hi * 1024 + r32 * 16;
    p0 = (f32x16){}; p1 = (f32x16){};
#pragma unroll
    for (int d0 = 0; d0 < 4; ++d0) {
        const bf16x8 b0 = *(const LAS bf16x8*)(kb + d0 * 2048), b1 = *(const LAS bf16x8*)(kb + d0 * 2048 + 512), q = *(const LAS bf16x8*)(qf + d0 * 1024);
        p0 = __builtin_amdgcn_mfma_f32_32x32x16_bf16(b0, q, p0, 0, 0, 0);
        p1 = __builtin_amdgcn_mfma_f32_32x32x16_bf16(b1, q, p1, 0, 0, 0);
    }
}
__device__ __forceinline__ void nsa_pv(f32x16 (&o)[2], const f32x16& p0, const f32x16& p1, const LAS unsigned char* vs, int lane, int hi) {
    bf16x8 pa[4];
#pragma unroll
    for (int k = 0; k < 4; ++k) {
        u32x4 w;
#pragma unroll
        for (int e = 0; e < 4; ++e) { const int r = (k & 1) * 8 + 2 * e; w[e] = (k < 2) ? pk2(p0[r], p0[r + 1]) : pk2(p1[r], p1[r + 1]); }
        pa[k] = __builtin_bit_cast(bf16x8, w);
    }
    const LAS unsigned char* vb = vs + ((lane >> 4) & 1) * 32 + (lane & 3) * 8 + (4 * hi + ((lane & 15) >> 2)) * 64;
#pragma unroll
    for (int dh = 0; dh < 2; ++dh)
#pragma unroll
        for (int k = 0; k < 4; ++k) {
            const s16x4 lo = nsa_vtr(vb + dh * 4096 + k * 1024), hi4 = nsa_vtr(vb + dh * 4096 + k * 1024 + 512);
            const bf16x8 vf = (bf16x8){lo[0], lo[1], lo[2], lo[3], hi4[0], hi4[1], hi4[2], hi4[3]};
            o[dh] = __builtin_amdgcn_mfma_f32_32x32x16_bf16(pa[k], vf, o[dh], 0, 0, 0);
        }
}
template <bool INIT>
__device__ __forceinline__ void nsa_accum(LAS float* ost, const f32x16 (&o)[2], float f, LAS float* wsf, int lane, int r32, int hi) {
    if (hi == 0) wsf[r32] = f;
    LDS_WAIT(); asm volatile("" ::: "memory");
#pragma unroll
    for (int r = 0; r < 16; ++r) {
        const float a = wsf[crow(r, hi)];
        if (INIT) { ost[r * 64 + lane] = a * o[0][r]; ost[(16 + r) * 64 + lane] = a * o[1][r]; }
        else { ost[r * 64 + lane] += a * o[0][r]; ost[(16 + r) * 64 + lane] += a * o[1][r]; }
    }
    LDS_WAIT(); asm volatile("" ::: "memory");
}

template <int MODE>
__device__ __forceinline__ void nsa_branch(const bf16* Kg, const bf16* Vg, int jlo, int jhi, unsigned anymask, unsigned mymask, int t, float slope,
                                           LAS unsigned char* lds, int tid, int lane, f32x16 (&o)[2], float& l_out) {
    const int r32 = lane & 31, hi = lane >> 5, wid = tid >> 6;
    LAS float* wsf = (LAS float*)(lds + NSA_WSF) + wid * 32;
    const LAS unsigned char* qf = lds + NSA_QF + wid * 4096 + lane * 16;
    constexpr float SC2 = 0.125f * 1.4426950408889634f;
    const float sl2 = slope * 1.4426950408889634f;
    float m = -1e29f, l = 0.f; o[0] = (f32x16){}; o[1] = (f32x16){};
    int j = jlo;
    if (MODE == 2) while (j <= jhi && !((anymask >> j) & 1u)) ++j;
    if (j > jhi) { l_out = 0.f; return; }
    u32x4 kreg = nsa_ldk(Kg, ZN_LD, 64 * j, tid), vreg = nsa_ldv(Vg, ZN_LD, 64 * j, tid);
    __syncthreads();
    *(LAS u32x4*)(lds + NSA_KS + tid * 16) = kreg; *(LAS u32x4*)(lds + NSA_VS + tid * 16) = vreg;
    __syncthreads();
    for (;;) {
        int jn = j + 1;
        if (MODE == 2) while (jn <= jhi && !((anymask >> jn) & 1u)) ++jn;
        const bool hn = jn <= jhi;
        if (hn) { kreg = nsa_ldk(Kg, ZN_LD, 64 * jn, tid); vreg = nsa_ldv(Vg, ZN_LD, 64 * jn, tid); }
        f32x16 p0, p1;
        nsa_qk(p0, p1, lds + NSA_KS, qf, r32, hi);
        const bool sel = (MODE == 2) ? (((mymask >> j) & 1u) != 0u) : true;
        const float base = sel ? sl2 * (float)(64 * j + 4 * hi - t) : -1e30f;
        float mx = -1e30f;
#pragma unroll
        for (int r = 0; r < 16; ++r) {
            const float c0 = (float)((r & 3) + 8 * (r >> 2));
            const float b0 = __builtin_fmaf(sl2, c0, base);
            p0[r] = __builtin_fmaf(p0[r], SC2, b0); p1[r] = __builtin_fmaf(p1[r], SC2, b0 + 32.f * sl2);
        }
        if (j == jhi || (MODE == 1 && j == jhi - 8)) {
#pragma unroll
            for (int r = 0; r < 16; ++r) {
                const int d0 = t - (64 * j + crow(r, hi)), d1 = d0 - 32;
                const bool v0 = d0 >= 0 && (MODE == 1 ? d0 < 512 : true), v1 = d1 >= 0 && (MODE == 1 ? d1 < 512 : true);
                p0[r] = v0 ? p0[r] : -1e30f; p1[r] = v1 ? p1[r] : -1e30f;
            }
        }
#pragma unroll
        for (int r = 0; r < 16; ++r) mx = fmaxf(mx, fmaxf(p0[r], p1[r]));
        mx = fmaxf(mx, __shfl_xor(mx, 32));
        const float mn = fmaxf(m, mx), alpha = __builtin_amdgcn_exp2f(m - mn);
        float ps = 0.f;
#pragma unroll
        for (int r = 0; r < 16; ++r) { p0[r] = __builtin_amdgcn_exp2f(p0[r] - mn); p1[r] = __builtin_amdgcn_exp2f(p1[r] - mn); ps += p0[r] + p1[r]; }
        ps += __shfl_xor(ps, 32);
        l = l * alpha + ps; m = mn;
        if (__any(alpha != 1.f)) {
            if (hi == 0) wsf[r32] = alpha;
            LDS_WAIT(); asm volatile("" ::: "memory");
#pragma unroll
            for (int r = 0; r < 16; ++r) { const float a = wsf[crow(r, hi)]; o[0][r] *= a; o[1][r] *= a; }
            LDS_WAIT(); asm volatile("" ::: "memory");
        }
        nsa_pv(o, p0, p1, lds + NSA_VS, lane, hi);
        __syncthreads();
        if (!hn) break;
        *(LAS u32x4*)(lds + NSA_KS + tid * 16) = kreg; *(LAS u32x4*)(lds + NSA_VS + tid * 16) = vreg;
        __syncthreads();
        j = jn;
    }
    l_out = l;
}

__device__ __forceinline__ void nsa_unit(const Frame& F, const Args& A, int b, int g, int qb) {
    unsigned char* ws = A.ws;
    const bf16* ZN = (const bf16*)(ws + WS_ZN); const bf16* KC = (const bf16*)(ws + WS_KCV); const bf16* VC = KC + 16 * 128 * 64; bf16* YB = (bf16*)(ws + WS_YAB) + (size_t)NTOK * 1024;
    LAS unsigned char* lds = F.lds;
    int lane_o = F.lane; asm volatile("" : "+v"(lane_o));
    const int wid = F.wave, lane = lane_o, tid = wid * 64 + lane, r32 = lane & 31, hi = lane >> 5, hg = r32 >> 3, ti = r32 & 7;
    const int tok = wid * 8 + ti, t = qb * 64 + tok, h = g * 4 + hg;
    const size_t row = (size_t)b * SEQ + t;
    const float slope = exp2f(-0.5f * (float)(h + 1));
    LAS float* wsf = (LAS float*)(lds + NSA_WSF) + wid * 32;
    LAS float* IMP = (LAS float*)(lds + NSA_IMP); LAS unsigned* MASK = (LAS unsigned*)(lds + NSA_MASK); LAS unsigned* ANYW = (LAS unsigned*)(lds + NSA_ANY);
    LAS unsigned char* qf = lds + NSA_QF + wid * 4096 + lane * 16;
    LAS float* ost = (LAS float*)(lds + NSA_OST) + wid * 2048;
    __syncthreads();
#pragma unroll
    for (int d0 = 0; d0 < 4; ++d0) *(LAS bf16x8*)(qf + d0 * 1024) = *(const bf16x8*)(ZN + row * ZN_LD + ZN_Q + h * 64 + d0 * 16 + hi * 8);
    const float gcmp = sigmoidf_(bf2f(ZN[row * ZN_LD + ZN_GATE + h])), gslc = sigmoidf_(bf2f(ZN[row * ZN_LD + ZN_GATE + 16 + h])), gwin = sigmoidf_(bf2f(ZN[row * ZN_LD + ZN_GATE + 32 + h]));
    {
        const bf16* KCb = KC + (size_t)(b * 4 + g) * 128 * 64; const bf16* VCb = VC + (size_t)(b * 4 + g) * 128 * 64;
        __syncthreads();
        *(LAS u32x4*)(lds + NSA_KS + tid * 16) = nsa_ldk(KCb, 64, 0, tid); *(LAS u32x4*)(lds + NSA_VS + tid * 16) = nsa_ldk(KCb, 64, 64, tid);
        __syncthreads();
        f32x16 a0, a1, b0, b1;
        nsa_qk(a0, a1, lds + NSA_KS, qf, r32, hi); nsa_qk(b0, b1, lds + NSA_VS, qf, r32, hi);
        {
            const u32x4 v0r = nsa_ldv(VCb, 64, 0, tid), v1r = nsa_ldv(VCb, 64, 64, tid);
            __syncthreads();
            *(LAS u32x4*)(lds + NSA_KS + tid * 16) = v0r; *(LAS u32x4*)(lds + NSA_VS + tid * 16) = v1r;
        }
        float mx = -1e30f;
#pragma unroll
        for (int r = 0; r < 16; ++r) {
            const int n = crow(r, hi);
            const int d00 = t - (16 * n + 31), d01 = d00 - 512, d10 = d00 - 1024, d11 = d00 - 1536;
            a0[r] = d00 >= 0 ? (a0[r] * 0.125f - slope * (float)d00) : -1e30f; a1[r] = d01 >= 0 ? (a1[r] * 0.125f - slope * (float)d01) : -1e30f;
            b0[r] = d10 >= 0 ? (b0[r] * 0.125f - slope * (float)d10) : -1e30f; b1[r] = d11 >= 0 ? (b1[r] * 0.125f - slope * (float)d11) : -1e30f;
            mx = fmaxf(fmaxf(mx, fmaxf(a0[r], a1[r])), fmaxf(b0[r], b1[r]));
        }
        mx = fmaxf(mx, __shfl_xor(mx, 32));
        float ps = 0.f;
#pragma unroll
        for (int r = 0; r < 16; ++r) {
            a0[r] = (a0[r] > -0.5e30f) ? __expf(a0[r] - mx) : 0.f; a1[r] = (a1[r] > -0.5e30f) ? __expf(a1[r] - mx) : 0.f;
            b0[r] = (b0[r] > -0.5e30f) ? __expf(b0[r] - mx) : 0.f; b1[r] = (b1[r] > -0.5e30f) ? __expf(b1[r] - mx) : 0.f;
            ps += (a0[r] + a1[r]) + (b0[r] + b1[r]);
        }
        ps += __shfl_xor(ps, 32);
        const float inv = 1.f / fmaxf(ps, 1e-30f);
#pragma unroll
        for (int r = 0; r < 16; ++r) { a0[r] *= inv; a1[r] *= inv; b0[r] *= inv; b1[r] *= inv; }
        float cprev = 0.f;
#pragma unroll
        for (int kk = 0; kk < 16; ++kk) {
            const int k = kk & 3, X = (kk >> 2) & 1, T = kk >> 3;
            float x0, x1, x2, x3;
            if (T == 0 && X == 0) { x0 = a0[4 * k]; x1 = a0[4 * k + 1]; x2 = a0[4 * k + 2]; x3 = a0[4 * k + 3]; }
            else if (T == 0) { x0 = a1[4 * k]; x1 = a1[4 * k + 1]; x2 = a1[4 * k + 2]; x3 = a1[4 * k + 3]; }
            else if (X == 0) { x0 = b0[4 * k]; x1 = b0[4 * k + 1]; x2 = b0[4 * k + 2]; x3 = b0[4 * k + 3]; }
            else { x0 = b1[4 * k]; x1 = b1[4 * k + 1]; x2 = b1[4 * k + 2]; x3 = b1[4 * k + 3]; }
            float av = (x0 + x1) + (x2 + 0.5f * x3), cv = 0.5f * x3;
            av += __shfl_xor(av, 8); av += __shfl_xor(av, 16); cv += __shfl_xor(cv, 8); cv += __shfl_xor(cv, 16);
            const float cp = __shfl_xor(cv, 32);
            const float impj = av + (hi ? cp : cprev);
            cprev = cp;
            if (hg == 0) IMP[tok * 33 + 2 * kk + hi] = impj;
        }
        __syncthreads();
        f32x16 oc[2]; oc[0] = (f32x16){}; oc[1] = (f32x16){};
        nsa_pv(oc, a0, a1, lds + NSA_KS, lane, hi); nsa_pv(oc, b0, b1, lds + NSA_VS, lane, hi);
        nsa_accum<true>(ost, oc, gcmp, wsf, lane, r32, hi);
        {
            int tid_o = tid; asm volatile("" : "+v"(tid_o));
            const int tk = tid_o >> 3, jq = tid_o & 7; unsigned bits = 0u;
            float sc[32];
#pragma unroll
            for (int jj = 0; jj < 32; ++jj) sc[jj] = (jj > qb) ? -1e30f : ((jj == 0 || jj == qb || jj == qb - 1) ? 1e30f : IMP[tk * 33 + jj]);
#pragma unroll
            for (int e = 0; e < 4; ++e) {
                const int j = jq * 4 + e;
                const float sj = (j > qb) ? -1e30f : ((j == 0 || j == qb || j == qb - 1) ? 1e30f : IMP[tk * 33 + j]);
                int cnt = 0;
#pragma unroll
                for (int jj = 0; jj < 32; ++jj) cnt += (sc[jj] > sj || (sc[jj] == sj && jj < j)) ? 1 : 0;
                if (cnt < 16 && sj > -0.5e30f) bits |= 1u << j;
            }
            bits |= __shfl_xor(bits, 1); bits |= __shfl_xor(bits, 2); bits |= __shfl_xor(bits, 4);
            if (jq == 0) MASK[tk] = bits;
        }
        __syncthreads();
        if (tid < 64) { unsigned v = MASK[tid]; v |= __shfl_xor(v, 1); v |= __shfl_xor(v, 2); v |= __shfl_xor(v, 4); v |= __shfl_xor(v, 8); v |= __shfl_xor(v, 16); v |= __shfl_xor(v, 32); if (tid == 0) ANYW[0] = v; }
        __syncthreads();
    }
    f32x16 o[2];
    const unsigned mymask = MASK[tok], anymask = ANYW[0];
    float lb;
#ifndef NSA_NO_WIN
    {
        const bf16* Kg = ZN + (size_t)b * SEQ * ZN_LD + ZN_KW + g * 64; const bf16* Vg = ZN + (size_t)b * SEQ * ZN_LD + ZN_VW + g * 64;
        nsa_branch<1>(Kg, Vg, qb >= 8 ? qb - 8 : 0, qb, 0u, 0u, t, slope, lds, tid, lane, o, lb);
        nsa_accum<false>(ost, o, gwin / fmaxf(lb, 1e-30f), wsf, lane, r32, hi);
    }
#endif
#ifndef NSA_NO_SEL
    {
        const bf16* Kg = ZN + (size_t)b * SEQ * ZN_LD + ZN_KS + g * 64; const bf16* Vg = ZN + (size_t)b * SEQ * ZN_LD + ZN_VS + g * 64;
        nsa_branch<2>(Kg, Vg, 0, qb, anymask, mymask, t, slope, lds, tid, lane, o, lb);
        nsa_accum<false>(ost, o, gslc / fmaxf(lb, 1e-30f), wsf, lane, r32, hi);
    }
#endif
    {
        int lane_s = lane; asm volatile("" : "+v"(lane_s));
        const int his = lane_s >> 5;
#pragma unroll
        for (int r = 0; r < 16; ++r) {
            const int q = crow(r, his), tq = qb * 64 + wid * 8 + (q & 7), hq = g * 4 + (q >> 3);
            bf16* dst = YB + ((size_t)b * SEQ + tq) * 1024 + hq * 64 + (lane_s & 31);
            dst[0] = (bf16)f2bf(ost[r * 64 + lane_s]); dst[32] = (bf16)f2bf(ost[(16 + r) * 64 + lane_s]);
        }
    }
}

constexpr int N_PHASES = 12;
template <int PHM> __global__ void __launch_bounds__(512, 2) mega_fwd(Args args) {
    extern __shared__ __attribute__((aligned(16))) unsigned char lds_raw[];
    Frame F;
    F.lds = (LAS unsigned char*)lds_raw;
    F.tid = threadIdx.x; F.lane = F.tid & 63; F.wave = __builtin_amdgcn_readfirstlane(F.tid >> 6);
    F.G = gridDim.x; { const int bx = blockIdx.x; F.vcu = (F.G % 8 == 0) ? (bx % 8) * (F.G / 8) + bx / 8 : bx; }
    F.in = nullptr;
    unsigned char* ws = args.ws;
    volatile LAS unsigned* MISC = (volatile LAS unsigned*)(F.lds + MISC_OFF);
    for (int u = F.tid; u < (LDS_BYTES - LDSCTL_OFF) / 4; u += 512) ((LAS unsigned*)(F.lds + LDSCTL_OFF))[u] = 0u;
    __syncthreads();
#if MK_ONE_LAUNCH
    XcdBarrier bar = xcd_barrier_post((unsigned*)(ws + WS_CTL) + CW_BAR, MISC + 8, F.tid);
#define GRID_BAR() do { PHASE_FRAME(); xcd_barrier(bar, Fp.tid); } while (0)
#else
#define GRID_BAR() do { } while (0)
#endif
    const int lo = args.ph_lo, hi = args.ph_hi;
#ifdef TPROBE_LO
    unsigned long long tp0_ = 0ull, tp1_ = 0ull;
#define TP(k) do { if ((k) == TPROBE_LO) tp0_ = __builtin_amdgcn_s_memrealtime(); if ((k) == TPROBE_HI) tp1_ = __builtin_amdgcn_s_memrealtime(); } while (0)
#define TPI_B(id) unsigned long long tpi_##id = __builtin_amdgcn_s_memrealtime()
#define TPI_E(id) do { if ((id) == TPROBE_LO) tp1_ += __builtin_amdgcn_s_memrealtime() - tpi_##id; } while (0)
#else
#define TPI_B(id) do { } while (0)
#define TPI_E(id) do { } while (0)
#define TP(k) do { } while (0)
#endif
#define PHASE_FRAME() Frame Fp = F; asm volatile("v_mbcnt_lo_u32_b32 %0, -1, 0\n\tv_mbcnt_hi_u32_b32 %0, -1, %0" : "=v"(Fp.lane)); asm volatile("" : "+s"(Fp.wave), "+s"(Fp.vcu)); Fp.tid = Fp.wave * 64 + Fp.lane
#define IN(k) (((PHM >> (k)) & 1) && lo <= (k) && (k) < hi)
#define SEAM(k) do { if (IN(k) && IN((k) + 1)) GRID_BAR(); } while (0)

    bf16* ZR = (bf16*)(ws + WS_ZR); bf16* ZN = (bf16*)(ws + WS_ZN); bf16* ZG = (bf16*)(ws + WS_ZG);
    float* rowsq1 = (float*)(ws + WS_CTL + CTL_ROWSQ1); float* rowsq2 = (float*)(ws + WS_CTL + CTL_ROWSQ2);

    TP(0);
    if (IN(0)) { PHASE_FRAME(); ph0_prologue(Fp, args); }
    SEAM(0);
    TP(1);
    if (IN(1)) {
        pg8::Gemm g{(const pg8::bf16_t*)(ws + WS_XN), (const pg8::bf16_t*)(ws + WS_WINT), NTOK, INCP, 2048};
        pg8::StaticOrder S; S.init(NTOK, INCP, F.G, (int)blockIdx.x);
        EpiProj E{ZR, ZN, ZG};
        pg8::gemm_phase<EpiProj, pg8::StaticOrder, true, true>(F.lds, g, S, E, F.wave);
    }
    SEAM(1);
    TP(2);
    if (IN(2)) { PHASE_FRAME(); ph2_build(Fp, args); }
    SEAM(2);
    TP(3);
    if (IN(3)) {
#ifndef NO_LORAGEMM
        {
            int kl = 256; asm volatile("" : "+s"(kl));
            pg8::Gemm g{(const pg8::bf16_t*)(ws + WS_A2), (const pg8::bf16_t*)(ws + WS_LORAT), 3 * NTOK, 3 * 1024, kl};
            CatOrder<32, 4, 3> S; S.init(F.G, (int)blockIdx.x);
            EpiLora E{(bf16*)(ws + WS_LORA), args.in[4], args.in[6]};
            pg8::gemm_phase<EpiLora, CatOrder<32, 4, 3>, true, true>(F.lds, g, S, E, F.wave);
        }
#endif
#ifndef NO_CMPGEMM
        {
            pg8::Gemm g{(const pg8::bf16_t*)(ws + WS_AG), (const pg8::bf16_t*)(ws + WS_W1T), 8 * 2048, 8 * 256, 512};
            int c2 = (int)((blockIdx.x + 64) % F.G); float* hp = (float*)(ws + WS_HPART);
            asm volatile("" : "+s"(c2), "+s"(hp));
            CatOrder<8, 1, 8> S; S.init(F.G, c2);
            EpiHpart E{hp};
            pg8::gemm_phase<EpiHpart, CatOrder<8, 1, 8>, true, true>(F.lds, g, S, E, F.wave);
        }
#endif
    }
    SEAM(3);
    TP(4);
    if (IN(4)) {
        { TPI_B(100); PHASE_FRAME(); for (int u = Fp.vcu; u < 128; u += Fp.G) cmp_finish_unit(Fp, args, u); __syncthreads(); TPI_E(100); }
        __syncthreads();
        { PHASE_FRAME(); LAS float* wl = (LAS float*)(Fp.lds + Fp.wave * 17408);
          unsigned long long tpr_ = 0ull, tst_ = 0ull;
          TPI_B(101); for (int ch = Fp.vcu * 8 + Fp.wave; ch < 2048; ch += Fp.G * 8) scan_chunk(Fp, args, ch, wl, tpr_, tst_); __syncthreads(); TPI_E(101);
#ifdef TPROBE_LO
          if (TPROBE_LO == 110) tp1_ += tpr_; if (TPROBE_LO == 111) tp1_ += tst_;
#endif
        }
    }
    SEAM(4);
    TP(5);
    if (IN(5)) {
#ifndef NO_R3
        { TPI_B(102); PHASE_FRAME(); for (int u = Fp.vcu; u < 256; u += Fp.G) r3_unit(Fp, args, u >> 2, u & 3); __syncthreads(); TPI_E(102); }
#endif
        __syncthreads();
        PHASE_FRAME();
        for (int p = Fp.vcu; p < 256; p += Fp.G) {
            const int bg = p >> 4, s = p & 15;
#ifndef NO_NSA
#pragma unroll 1
            for (int k2 = 0; k2 < 2; ++k2) nsa_unit(Fp, args, bg >> 2, bg & 3, k2 ? s : 31 - s);
#endif
        }
    }
    SEAM(5);
    TP(6);
    if (IN(6)) {
        { TPI_B(103); PHASE_FRAME(); r4_all(Fp, args); __syncthreads(); TPI_E(103); }
        __syncthreads();
        { PHASE_FRAME(); ph_cvt_mlp(Fp, args); }
    }
    SEAM(6);
    TP(7);
    if (IN(7)) {
        pg8::Gemm g{(const pg8::bf16_t*)(ws + WS_YAB), (const pg8::bf16_t*)(ws + WS_WOUTT), 2 * NTOK, 2 * 2048, 1024};
        PairOrder<32, 8> S; S.init(F.G, (int)blockIdx.x);
        EpiMerge E{ZG, (bf16*)(ws + WS_MIXED)};
        pg8::gemm_phase<EpiMerge, PairOrder<32, 8>, false, true>(F.lds, g, S, E, F.wave);
    }
    SEAM(7);
    TP(8);
    if (IN(8)) {
        pg8::Gemm g{(const pg8::bf16_t*)(ws + WS_MIXED), (const pg8::bf16_t*)(ws + WS_WOT), NTOK, 2048, 2048};
        pg8::StaticOrder S; S.init(NTOK, 2048, F.G, (int)blockIdx.x);
        EpiWo E{args.in[0], args.out, (bf16*)(ws + WS_H1B), rowsq1};
        pg8::gemm_phase<EpiWo, pg8::StaticOrder, false, true>(F.lds, g, S, E, F.wave);
    }
    SEAM(8);
    TP(9);
    if (IN(9)) {
        pg8::Gemm g{(const pg8::bf16_t*)(ws + WS_H1B), (const pg8::bf16_t*)(ws + WS_UPT), NTOK, DFF, 2048};
        pg8::StaticOrder S; S.init(NTOK, DFF, F.G, (int)blockIdx.x);
        EpiUp E{rowsq1, (bf16*)(ws + WS_ACT)};
        pg8::gemm_phase<EpiUp, pg8::StaticOrder, true, true>(F.lds, g, S, E, F.wave);
    }
    SEAM(9);
    TP(10);
    if (IN(10)) {
        pg8::Gemm g{(const pg8::bf16_t*)(ws + WS_ACT), (const pg8::bf16_t*)(ws + WS_DOWNT), NTOK, 2048, DFF};
        pg8::StaticOrder S; S.init(NTOK, 2048, F.G, (int)blockIdx.x);
        EpiDown E{args.out, rowsq2};
        pg8::gemm_phase<EpiDown, pg8::StaticOrder, false, true>(F.lds, g, S, E, F.wave);
    }
    SEAM(10);
    TP(11);
    if (IN(11)) {
        PHASE_FRAME();
        const float* nf = args.in[26];
        const int gw = Fp.vcu * 8 + Fp.wave, NGW = Fp.G * 8;
        for (int m = gw; m < NTOK; m += NGW) {
            const float rs = rsqrtf(__hip_atomic_load(rowsq2 + m, __ATOMIC_RELAXED, __HIP_MEMORY_SCOPE_AGENT) * (1.f / DM) + 1e-5f);
            f32x4* o = (f32x4*)(args.out + (size_t)m * DM) + Fp.lane;
#pragma unroll
            for (int j = 0; j < 8; ++j) { const f32x4 g = *((const f32x4*)nf + Fp.lane + 64 * j); f32x4 v = o[64 * j]; v = v * rs * g; o[64 * j] = v; }
        }
    }
    TP(12);
#ifdef TPROBE_LO
    { const unsigned long long te_ = __builtin_amdgcn_s_memrealtime(), dl_ = (tp1_ - tp0_) * TPROBE_MUL;
      while (__builtin_amdgcn_s_memrealtime() - te_ < dl_) __builtin_amdgcn_s_sleep(8); }
#endif
#undef IN
#undef SEAM
}

typedef void (*kern_t)(Args);
extern "C" void kernel_launch(void* const* d_in, const int* in_sizes, int n_in, void* d_out, int out_size, void* d_ws, size_t ws_size, hipStream_t stream) {
    static int grid = 0;
#if MK_ONE_LAUNCH
    static const kern_t kerns[1] = { mega_fwd<0xFFF> };
    constexpr int NK = 1;
#else
    static const kern_t kerns[12] = { mega_fwd<1>, mega_fwd<2>, mega_fwd<4>, mega_fwd<8>, mega_fwd<16>, mega_fwd<32>, mega_fwd<64>, mega_fwd<128>, mega_fwd<256>, mega_fwd<512>, mega_fwd<1024>, mega_fwd<2048> };
    constexpr int NK = 12;
#endif
    if (grid == 0) {
        if (n_in != 27 || in_sizes[0] != NTOK * DM || out_size != NTOK * DM || ws_size < WS_END) { fprintf(stderr, "kernel_launch: unexpected problem shape / workspace (%d inputs, ws %zu)\n", n_in, ws_size); grid = -1; return; }
        int dev = 0, cus = 0, per_cu = 0;
        if (hipGetDevice(&dev) != hipSuccess || hipDeviceGetAttribute(&cus, hipDeviceAttributeMultiprocessorCount, dev) != hipSuccess) { grid = -1; return; }
        for (int k = 0; k < NK; ++k) {
            if (hipFuncSetAttribute((const void*)kerns[k], hipFuncAttributeMaxDynamicSharedMemorySize, LDS_BYTES) != hipSuccess) { grid = -1; return; }
            if (hipOccupancyMaxActiveBlocksPerMultiprocessor(&per_cu, (const void*)kerns[k], 512, LDS_BYTES) != hipSuccess || per_cu < 1) { fprintf(stderr, "kernel_launch: occupancy query reports %d blocks/CU\n", per_cu); grid = -1; (void)hipGetLastError(); return; }
        }
        grid = cus;
    }
    if (grid < 0) return;
    (void)hipMemsetAsync((char*)d_ws + WS_CTL, 0, CTL_ZERO_BYTES, stream);
    Args a{};
    for (int i = 0; i < 27; ++i) a.in[i] = (const float*)d_in[i];
    a.out = (float*)d_out; a.ws = (unsigned char*)d_ws;
#if MK_ONE_LAUNCH
    a.ph_lo = 0; a.ph_hi = N_PHASES; a.li = 0;
    hipLaunchKernelGGL(kerns[0], dim3(grid), dim3(512), LDS_BYTES, stream, a);
#else
    for (int p = 0; p < N_PHASES; ++p) { a.ph_lo = p; a.ph_hi = p + 1; a.li = p; hipLaunchKernelGGL(kerns[p], dim3(grid), dim3(512), LDS_BYTES, stream, a); }
#endif
}
```
